# Optimizing an MI355X kernel written in HIP

```python
import math
import jax, jax.numpy as jnp
from jax import lax
import numpy as np

D_MODEL = 2048
BATCH = 2
SEQ = 4096
DEPTH = 1

CHUNK = 64
PLE_DIM = 256
D_MIX = D_MODEL
RW_WIDTH = D_MIX // 2
RW_HEAD = 64
RW_HEADS = RW_WIDTH // RW_HEAD
RW_DECAY_LORA = 64
RW_ICLR_LORA = 64
DS_WIDTH = D_MIX - RW_WIDTH
DS_HEAD = 64
DS_HEADS = DS_WIDTH // DS_HEAD
DS_Q_RANK = 384
DS_KV_RANK = 256
IDX_HEADS = 16
IDX_DIM = 64
TOPK_MAX = 256
Q_BLOCK = 128
NUM_BUCKETS = 32
MAX_DISTANCE = 128
NORM_EPS = 1e-6
GN_EPS = 64e-5
SHIFTED_COLS = 3 * RW_WIDTH + RW_DECAY_LORA + RW_ICLR_LORA
D_IN = SHIFTED_COLS + RW_WIDTH + DS_Q_RANK + DS_KV_RANK + IDX_DIM + IDX_HEADS + DS_WIDTH

kernel_name = "hybrid_rwkv7_dsa_parallel_heads"


def _split_points(sizes):
    pts, acc = [], 0
    for s in sizes[:-1]:
        acc += s
        pts.append(acc)
    return pts


def rms_norm(x, g, eps=NORM_EPS):
    xf = x.astype(jnp.float32)
    y = xf * lax.rsqrt(jnp.mean(xf * xf, axis=-1, keepdims=True) + eps)
    return (y * g.astype(jnp.float32)).astype(x.dtype)


def t5_bucket(rel):
    nb = NUM_BUCKETS // 2
    max_exact = nb // 2
    ret = jnp.where(rel > 0, nb, 0)
    n = jnp.abs(rel)
    nf = jnp.maximum(n, 1).astype(jnp.float32)
    large = max_exact + (jnp.log(nf / max_exact) / math.log(MAX_DISTANCE / max_exact)
                         * (nb - max_exact)).astype(jnp.int32)
    large = jnp.minimum(large, nb - 1)
    return ret + jnp.where(n < max_exact, n, large)


def rwkv7_mixer(z, mu, w0, w_up, a0, a_up, k_k, k_a, r_k, ln_g, ln_b):
    B, T, _ = z.shape
    H, N = RW_HEADS, RW_HEAD
    f32 = jnp.float32
    z_prev = jnp.pad(z, ((0, 0), (1, 0), (0, 0)))[:, :-1]
    z = z + mu * (z_prev - z)
    r, k, v, wd, ad = jnp.split(z, [RW_WIDTH, 2 * RW_WIDTH, 3 * RW_WIDTH,
                                    3 * RW_WIDTH + RW_DECAY_LORA], axis=-1)
    w_log = -jax.nn.softplus(-(w0 + jnp.tanh(wd) @ w_up)) - 0.5
    decay = jnp.exp(-jnp.exp(w_log.astype(f32)))
    a = jax.nn.sigmoid(a0 + ad @ a_up).astype(f32)
    heads = lambda t: t.astype(f32).reshape(B, T, H, N)
    kk = heads(k * k_k)
    kk = kk / jnp.maximum(jnp.sqrt(jnp.sum(kk * kk, axis=-1, keepdims=True)), 1e-12)
    k = k.astype(f32) * (1.0 + (a - 1.0) * k_a.astype(f32))
    rh, kh, vh, ah, wh = heads(r), heads(k), heads(v), heads(a), heads(decay)
    a_vec = -kk
    b_vec = kk * ah

    def step(S, inp):
        r_t, w_t, k_t, v_t, a_t, b_t = inp
        Sa = jnp.einsum('bhvk,bhk->bhv', S, a_t)
        S = (S * w_t[:, :, None, :] + Sa[..., None] * b_t[:, :, None, :]
             + v_t[..., None] * k_t[:, :, None, :])
        y = jnp.einsum('bhvk,bhk->bhv', S, r_t)
        return S, y

    tm = lambda t: jnp.moveaxis(t, 1, 0)
    S0 = jnp.zeros((B, H, N, N), f32)
    _, y = lax.scan(step, S0, (tm(rh), tm(wh), tm(kh), tm(vh), tm(a_vec), tm(b_vec)))
    y = jnp.moveaxis(y, 0, 1)
    mean = jnp.mean(y, axis=-1, keepdims=True)
    var = jnp.mean(jnp.square(y - mean), axis=-1, keepdims=True)
    y = (y - mean) * lax.rsqrt(var + GN_EPS)
    y = y * ln_g.astype(f32).reshape(H, N) + ln_b.astype(f32).reshape(H, N)
    bonus = jnp.sum(rh * kh * r_k.astype(f32), axis=-1, keepdims=True) * vh
    return (y + bonus).reshape(B, T, RW_WIDTH).astype(z.dtype)


def dsa_mixer(q_lat, kv_lat, k_idx, w_idx, q_norm_g, kv_norm_g, ik_norm_g,
              w_uq, w_uk, w_uv, iw_q, rel_bias):
    B, T, _ = q_lat.shape
    H, DH, R = DS_HEADS, DS_HEAD, DS_KV_RANK
    f32 = jnp.float32
    q_lat = rms_norm(q_lat, q_norm_g)
    c_kv = rms_norm(kv_lat, kv_norm_g)
    q = (q_lat @ w_uq).reshape(B, T, H, DH)
    q_abs = jnp.einsum('bthd,rhd->bthr', q, w_uk) * (DH ** -0.5)
    q_idx = (q_lat @ iw_q).reshape(B, T, IDX_HEADS, IDX_DIM)
    k_idx = rms_norm(k_idx, ik_norm_g)
    w_idx = w_idx * (IDX_HEADS ** -0.5 * IDX_DIM ** -0.5)
    top_k = min(TOPK_MAX, T // 4)
    nb = T // Q_BLOCK
    blocks = lambda t: jnp.moveaxis(t.reshape(B, nb, Q_BLOCK, *t.shape[2:]), 1, 0)
    key_pos = jnp.arange(T, dtype=jnp.int32)
    bias_tab = rel_bias.astype(f32)

    def attend_block(args):
        qa, qi, wi, q0 = args
        q_pos = q0 + jnp.arange(Q_BLOCK, dtype=jnp.int32)
        limit = (q_pos // CHUNK + 1) * CHUNK
        admissible = key_pos[None, :] < limit[:, None]
        logit_i = jnp.einsum('bqhd,bsd->bqhs', qi, k_idx)
        score = jnp.einsum('bqh,bqhs->bqs', wi, jax.nn.relu(logit_i)).astype(f32)
        score = jnp.where(admissible[None], score, -jnp.inf)
        _, sel = lax.top_k(score, top_k)
        valid = sel < limit[None, :, None]
        kv_sel = jax.vmap(lambda c, idx: c[idx])(c_kv, sel)
        bias = bias_tab[t5_bucket(sel - q_pos[None, :, None])]
        logits = (jnp.einsum('bqhr,bqkr->bqhk', qa, kv_sel).astype(f32)
                  + jnp.moveaxis(bias, -1, 2))
        logits = jnp.where(valid[:, :, None, :], logits, -jnp.inf)
        probs = jax.nn.softmax(logits, axis=-1).astype(c_kv.dtype)
        o_lat = jnp.einsum('bqhk,bqkr->bqhr', probs, kv_sel)
        return jnp.einsum('bqhr,rhd->bqhd', o_lat, w_uv)

    starts = jnp.arange(nb, dtype=jnp.int32) * Q_BLOCK
    out = lax.map(attend_block, (blocks(q_abs), blocks(q_idx), blocks(w_idx), starts))
    return jnp.moveaxis(out, 0, 1).reshape(B, T, DS_WIDTH)


def setup_inputs(seed: int = 0) -> dict:
    key = jax.random.key(seed)
    ks = jax.random.split(key, 26)
    f32 = jnp.float32
    nrm = lambda k, shape, scale: scale * jax.random.normal(k, shape, f32)
    L = DEPTH
    return {
        "x": nrm(ks[0], (BATCH, SEQ, D_MODEL), 1.0),
        "p": nrm(ks[1], (DEPTH, BATCH, SEQ, PLE_DIM), 1.0),
        "w_in": nrm(ks[2], (L, D_MODEL, D_IN), D_MODEL ** -0.5),
        "norm_g": 1.0 + nrm(ks[3], (L, D_MODEL), 0.02),
        "rw_mu": jax.random.uniform(ks[4], (L, SHIFTED_COLS), f32),
        "rw_w0": nrm(ks[5], (L, RW_WIDTH), 0.5),
        "rw_w_up": nrm(ks[6], (L, RW_DECAY_LORA, RW_WIDTH), 0.5 * RW_DECAY_LORA ** -0.5),
        "rw_a0": nrm(ks[7], (L, RW_WIDTH), 0.5),
        "rw_a_up": nrm(ks[8], (L, RW_ICLR_LORA, RW_WIDTH), 0.5 * RW_ICLR_LORA ** -0.5),
        "rw_k_k": 1.0 + nrm(ks[9], (L, RW_WIDTH), 0.1),
        "rw_k_a": 1.0 + nrm(ks[10], (L, RW_WIDTH), 0.1),
        "rw_r_k": nrm(ks[11], (L, RW_HEADS, RW_HEAD), 0.1),
        "rw_ln_g": 1.0 + nrm(ks[12], (L, RW_WIDTH), 0.02),
        "rw_ln_b": nrm(ks[13], (L, RW_WIDTH), 0.02),
        "ds_q_norm_g": 1.0 + nrm(ks[14], (L, DS_Q_RANK), 0.02),
        "ds_kv_norm_g": 1.0 + nrm(ks[15], (L, DS_KV_RANK), 0.02),
        "idx_k_norm_g": 1.0 + nrm(ks[16], (L, IDX_DIM), 0.02),
        "ds_w_uq": nrm(ks[17], (L, DS_Q_RANK, DS_HEADS * DS_HEAD), DS_Q_RANK ** -0.5),
        "ds_w_uk": nrm(ks[18], (L, DS_KV_RANK, DS_HEADS, DS_HEAD), DS_KV_RANK ** -0.5),
        "ds_w_uv": nrm(ks[19], (L, DS_KV_RANK, DS_HEADS, DS_HEAD), DS_KV_RANK ** -0.5),
        "idx_w_q": nrm(ks[20], (L, DS_Q_RANK, IDX_HEADS * IDX_DIM), DS_Q_RANK ** -0.5),
        "rel_bias": nrm(ks[21], (NUM_BUCKETS, DS_HEADS), 0.5),
        "w_out": nrm(ks[22], (L, D_MIX, D_MODEL), D_MIX ** -0.5),
        "ple_w": nrm(ks[23], (L, PLE_DIM, D_MODEL), PLE_DIM ** -0.5),
        "ple_gate_w": nrm(ks[24], (L, D_MODEL, D_MODEL), D_MODEL ** -0.5),
        "final_g": 1.0 + nrm(ks[25], (D_MODEL,), 0.02),
    }


def reference(x, p, w_in, norm_g, rw_mu, rw_w0, rw_w_up, rw_a0, rw_a_up, rw_k_k, rw_k_a,
              rw_r_k, rw_ln_g, rw_ln_b, ds_q_norm_g, ds_kv_norm_g, idx_k_norm_g, ds_w_uq,
              ds_w_uk, ds_w_uv, idx_w_q, rel_bias, w_out, ple_w, ple_gate_w, final_g):
    splits = _split_points([SHIFTED_COLS, RW_WIDTH, DS_Q_RANK, DS_KV_RANK,
                            IDX_DIM, IDX_HEADS, DS_WIDTH])
    h = x
    for i in range(DEPTH):
        xn = rms_norm(h, norm_g[i])
        z = xn @ w_in[i]
        z_rw, g_rw, q_lat, kv_lat, k_idx, w_idx, g_ds = jnp.split(z, splits, axis=-1)
        o_rw = rwkv7_mixer(z_rw, rw_mu[i], rw_w0[i], rw_w_up[i], rw_a0[i], rw_a_up[i],
                           rw_k_k[i], rw_k_a[i], rw_r_k[i], rw_ln_g[i], rw_ln_b[i])
        o_ds = dsa_mixer(q_lat, kv_lat, k_idx, w_idx, ds_q_norm_g[i], ds_kv_norm_g[i],
                         idx_k_norm_g[i], ds_w_uq[i], ds_w_uk[i], ds_w_uv[i], idx_w_q[i], rel_bias)
        mixed = jnp.concatenate([o_rw * jax.nn.silu(g_rw), o_ds * jax.nn.silu(g_ds)], axis=-1)
        h = h + mixed @ w_out[i]
        h = h + (p[i] @ ple_w[i]) * jax.nn.sigmoid(h @ ple_gate_w[i])
    return rms_norm(h, final_g)
```

```cpp
#include <hip/hip_runtime.h>
#include <hip/hip_cooperative_groups.h>
#include <cstdio>
#include <cstdint>
namespace cg = cooperative_groups;

namespace pg8 {
#define PG8_LAS __attribute__((address_space(3)))
typedef unsigned short bf16_t;
typedef short bf16x8 __attribute__((ext_vector_type(8)));
typedef float f32x4 __attribute__((ext_vector_type(4)));
typedef unsigned u32x4 __attribute__((ext_vector_type(4)));
constexpr int BM = 256, BK = 64, HALF = 128, HTB = HALF * BK * 2  , STAGE_BYTES = 8 * HTB, NXCD = 8, WGM = 8;

__host__ __device__ __forceinline__ int lds_byte(int r, int c) { const int st = (r >> 4) * 2 + (c >> 5), rr = r & 15, cc = c & 31, ob = rr * 64 + cc * 2; return st * 1024 + (ob ^ (((ob >> 9) & 1) << 5)); }
__host__ __device__ __forceinline__ void stage_rc(int b, int& R, int& C) { const int st = b / 1024, sb = b % 1024, swz = sb ^ (((sb >> 9) & 1) << 5); R = (st >> 1) * 16 + swz / 64; C = (st & 1) * 32 + (swz % 64) / 2; }
__host__ __device__ __forceinline__ int perm32(int rho) { const int n = rho >> 4, i = rho & 15; return 8 * (i >> 2) + 4 * n + (i & 3); }

struct Unit { int pm, pn; };
struct Gemm { const bf16_t* A; const bf16_t* Bt; int M, N, K; };

struct StaticOrder {
    int nM, nN, nwg, G, c;
    __host__ __device__ void init(int M, int N, int G_, int c_) { nM = M / BM; nN = N / BM; nwg = nM * nN; G = G_; c = c_; }
    __host__ __device__ bool next(int i, Unit& u) const {
        const long L = (long)i * G + c; if (L >= nwg) return false;
        int wgid = (int)L; { const int q = nwg / NXCD, r = nwg % NXCD, xcd = wgid % NXCD, off = wgid / NXCD; wgid = (xcd < r ? xcd * (q + 1) : r * (q + 1) + (xcd - r) * q) + off; }
        const int nig = WGM * nN, gid = wgid / nig, fm = gid * WGM, gsz = (nM - fm) < WGM ? (nM - fm) : WGM;
        u.pm = fm + ((wgid % nig) % gsz); u.pn = (wgid % nig) / gsz; return true;
    }
    __device__ __forceinline__ void a_ready(const Unit&) const {}
    __device__ __forceinline__ void done(const Unit&) const {}
};

__device__ __forceinline__ unsigned cvt_pk_bf16(float lo, float hi) { unsigned r; asm volatile("v_cvt_pk_bf16_f32 %0, %1, %2" : "=v"(r) : "v"(lo), "v"(hi)); return r; }
__device__ __forceinline__ float silu_f(float v) { return v / (1.0f + __expf(-v)); }
__device__ __forceinline__ float sigmoid_f(float v) { return 1.0f / (1.0f + __expf(-v)); }
__device__ __forceinline__ u32x4 pack8(const f32x4& v0, const f32x4& v1) { u32x4 w; w.x = cvt_pk_bf16(v0[0], v0[1]); w.y = cvt_pk_bf16(v0[2], v0[3]); w.z = cvt_pk_bf16(v1[0], v1[1]); w.w = cvt_pk_bf16(v1[2], v1[3]); return w; }

struct EpiZ {
    static constexpr bool PERM = true, AFTER_DRAIN = false;
    bf16_t* zrkv; bf16_t* gates; float* zsm;
    __device__ __forceinline__ void operator()(const f32x4 (&acc)[2][2][4][2], const Unit& u, int wr, int wc, int fr, int fq) const {
        const int row0 = u.pm * BM + wr * 64 + fr, colw = wc * 32 + 8 * fq;
        if (u.pn < 12) {
#pragma unroll
            for (int ai = 0; ai < 2; ++ai)
#pragma unroll
                for (int m = 0; m < 4; ++m) { bf16_t* rowp = zrkv + (size_t)(row0 + ai * HALF + m * 16) * 3072 + u.pn * BM + colw;
#pragma unroll
                    for (int bj = 0; bj < 2; ++bj) *(u32x4*)(rowp + bj * HALF) = pack8(acc[ai][bj][m][0], acc[ai][bj][m][1]); }
        } else if (u.pn < 20) {
#pragma unroll
            for (int ai = 0; ai < 2; ++ai)
#pragma unroll
                for (int m = 0; m < 4; ++m) { bf16_t* rowp = gates + (size_t)(row0 + ai * HALF + m * 16) * 2048 + (u.pn - 12) * BM + colw;
#pragma unroll
                    for (int bj = 0; bj < 2; ++bj) { f32x4 v0 = acc[ai][bj][m][0], v1 = acc[ai][bj][m][1];
#pragma unroll
                        for (int j = 0; j < 4; ++j) { v0[j] = silu_f(v0[j]); v1[j] = silu_f(v1[j]); }
                        *(u32x4*)(rowp + bj * HALF) = pack8(v0, v1); } }
        } else {
#pragma unroll
            for (int ai = 0; ai < 2; ++ai)
#pragma unroll
                for (int m = 0; m < 4; ++m) { float* rowp = zsm + (size_t)(row0 + ai * HALF + m * 16) * 1024 + (u.pn - 20) * BM + colw;
#pragma unroll
                    for (int bj = 0; bj < 2; ++bj) { *(f32x4*)(rowp + bj * HALF) = acc[ai][bj][m][0]; *(f32x4*)(rowp + bj * HALF + 4) = acc[ai][bj][m][1]; } }
        }
    }
};
struct EpiBf16Split {
    static constexpr bool PERM = true, AFTER_DRAIN = false;
    bf16_t* O0; int ld0; int nt0; bf16_t* O1; int ld1;
    __device__ __forceinline__ void operator()(const f32x4 (&acc)[2][2][4][2], const Unit& u, int wr, int wc, int fr, int fq) const {
        const int row0 = u.pm * BM + wr * 64 + fr, colw = wc * 32 + 8 * fq;
        bf16_t* base; int ld, ct;
        if (u.pn < nt0) { base = O0; ld = ld0; ct = u.pn; } else { base = O1; ld = ld1; ct = u.pn - nt0; }
#pragma unroll
        for (int ai = 0; ai < 2; ++ai)
#pragma unroll
            for (int m = 0; m < 4; ++m) { bf16_t* rowp = base + (size_t)(row0 + ai * HALF + m * 16) * ld + ct * BM + colw;
#pragma unroll
                for (int bj = 0; bj < 2; ++bj) *(u32x4*)(rowp + bj * HALF) = pack8(acc[ai][bj][m][0], acc[ai][bj][m][1]); }
    }
};
struct EpiH {
    static constexpr bool PERM = true, AFTER_DRAIN = false;
    const float* x; float* h; bf16_t* hb;
    __device__ __forceinline__ void operator()(const f32x4 (&acc)[2][2][4][2], const Unit& u, int wr, int wc, int fr, int fq) const {
        const int row0 = u.pm * BM + wr * 64 + fr, col0 = u.pn * BM + wc * 32 + 8 * fq;
#pragma unroll
        for (int ai = 0; ai < 2; ++ai)
#pragma unroll
            for (int m = 0; m < 4; ++m) { const size_t ro = (size_t)(row0 + ai * HALF + m * 16) * 2048 + col0;
#pragma unroll
                for (int bj = 0; bj < 2; ++bj) { const size_t o = ro + bj * HALF;
                    const f32x4 v0 = acc[ai][bj][m][0] + *(const f32x4*)(x + o), v1 = acc[ai][bj][m][1] + *(const f32x4*)(x + o + 4);
                    *(f32x4*)(h + o) = v0; *(f32x4*)(h + o + 4) = v1; *(u32x4*)(hb + o) = pack8(v0, v1); } }
    }
};
struct EpiOut {
    static constexpr bool PERM = true, AFTER_DRAIN = false;
    float* h; const bf16_t* ple; float* part;
    __device__ __forceinline__ void operator()(const f32x4 (&acc)[2][2][4][2], const Unit& u, int wr, int wc, int fr, int fq) const {
        const int row0 = u.pm * BM + wr * 64 + fr, col0 = u.pn * BM + wc * 32 + 8 * fq;
#pragma unroll
        for (int ai = 0; ai < 2; ++ai)
#pragma unroll
            for (int m = 0; m < 4; ++m) { const int row = row0 + ai * HALF + m * 16; const size_t ro = (size_t)row * 2048 + col0; float ss = 0.f;
#pragma unroll
                for (int bj = 0; bj < 2; ++bj) { const size_t o = ro + bj * HALF;
                    const u32x4 pw = *(const u32x4*)(ple + o);
                    f32x4 p0, p1; p0[0] = __builtin_bit_cast(float, pw.x << 16); p0[1] = __builtin_bit_cast(float, pw.x & 0xffff0000u); p0[2] = __builtin_bit_cast(float, pw.y << 16); p0[3] = __builtin_bit_cast(float, pw.y & 0xffff0000u);
                    p1[0] = __builtin_bit_cast(float, pw.z << 16); p1[1] = __builtin_bit_cast(float, pw.z & 0xffff0000u); p1[2] = __builtin_bit_cast(float, pw.w << 16); p1[3] = __builtin_bit_cast(float, pw.w & 0xffff0000u);
                    f32x4 v0 = *(const f32x4*)(h + o), v1 = *(const f32x4*)(h + o + 4);
#pragma unroll
                    for (int j = 0; j < 4; ++j) { v0[j] += p0[j] * sigmoid_f(acc[ai][bj][m][0][j]); v1[j] += p1[j] * sigmoid_f(acc[ai][bj][m][1][j]); ss += v0[j] * v0[j] + v1[j] * v1[j]; }
                    *(f32x4*)(h + o) = v0; *(f32x4*)(h + o + 4) = v1; }
                ss += __shfl_xor(ss, 16); ss += __shfl_xor(ss, 32);
                if (fq == 0) part[(size_t)row * 32 + u.pn * 4 + wc] = ss; }
    }
};

template <class Epi, class Sched, bool ALIGN_EPI = false, bool SP2 = false>
__device__ __forceinline__ void gemm_phase(PG8_LAS unsigned char* lds, const Gemm g, const Sched& S, const Epi& E) {
    const int tid = threadIdx.x, wid = __builtin_amdgcn_readfirstlane(tid >> 6), lane = tid & 63, wr = wid >> 2, wc = wid & 3, fr = lane & 15, fq = lane >> 4;
    const int K = g.K, nt = K / BK;
    unsigned voffA[2], voffB[2];
#pragma unroll
    for (int i = 0; i < 2; ++i) { int R, C; stage_rc(tid * 16 + i * 8192, R, C); const int Rb = Epi::PERM ? ((R & ~31) + perm32(R & 31)) : R;
        voffA[i] = (unsigned)(R * K + C) * 2u; voffB[i] = (unsigned)(Rb * K + C) * 2u; }
    const size_t kstep = (size_t)(BK * 2);
    const size_t hstep = (size_t)HALF * K * 2;
    const size_t tstep = 2 * hstep;
    const unsigned ldsw = (unsigned)wid * 1024u;
    const int aoff = lds_byte(wr * 64 + fr, fq * 8), boff = lds_byte(wc * 32 + fr, fq * 8);
#define PG8_SA(b, h) (((b) * 2 + (h)) * HTB)
#define PG8_SB(b, h) ((4 + (b) * 2 + (h)) * HTB)
#define PG8_STAGE(bufoff, gbase, voff) do { _Pragma("unroll") for (int _i = 0; _i < 2; ++_i) \
        __builtin_amdgcn_global_load_lds((const unsigned*)((const char*)(gbase) + (voff)[_i]), (PG8_LAS unsigned*)(lds + (bufoff) + ldsw + _i * 8192), 16, 0, 0); } while (0)
#define PG8_LDA(dst, b, h) do { _Pragma("unroll") for (int m = 0; m < 4; ++m) _Pragma("unroll") for (int k = 0; k < 2; ++k) dst[m][k] = *(const PG8_LAS bf16x8*)(lds + PG8_SA(b, h) + aoff + m * 2048 + k * 1024); } while (0)
#define PG8_LDB(dst, b, h) do { _Pragma("unroll") for (int n = 0; n < 2; ++n) _Pragma("unroll") for (int k = 0; k < 2; ++k) dst[n][k] = *(const PG8_LAS bf16x8*)(lds + PG8_SB(b, h) + boff + n * 2048 + k * 1024); } while (0)
#define PG8_MMA(ai, bj, At, Bt) do { __builtin_amdgcn_s_setprio(1); _Pragma("unroll") for (int m = 0; m < 4; ++m) _Pragma("unroll") for (int n = 0; n < 2; ++n) _Pragma("unroll") for (int k = 0; k < 2; ++k) \
        acc[ai][bj][m][n] = __builtin_amdgcn_mfma_f32_16x16x32_bf16(Bt[n][k], At[m][k], acc[ai][bj][m][n], 0, 0, 0); __builtin_amdgcn_s_setprio(0); } while (0)
#define PG8_WAIT_V(n) asm volatile("s_waitcnt vmcnt(" #n ")" ::: "memory")
#define PG8_WAIT_L(n) asm volatile("s_waitcnt lgkmcnt(" #n ")" ::: "memory")
#define PG8_BAR __builtin_amdgcn_s_barrier()
#define PG8_SCHED __builtin_amdgcn_sched_barrier(0)
    Unit cur, nxt; int ui = 0;
    if (!S.next(0, cur)) return;
    f32x4 acc[2][2][4][2];
#pragma unroll
    for (int a = 0; a < 2; ++a)
#pragma unroll
        for (int b = 0; b < 2; ++b)
#pragma unroll
            for (int m = 0; m < 4; ++m)
#pragma unroll
                for (int n = 0; n < 2; ++n) acc[a][b][m][n] = (f32x4){0.f, 0.f, 0.f, 0.f};
    bf16x8 At[4][2], B0[2][2], B1[2][2];
    const char* cA = (const char*)g.A + (size_t)cur.pm * tstep; const char* cB = (const char*)g.Bt + (size_t)cur.pn * tstep;
    S.a_ready(cur);
    if constexpr (SP2) {
        PG8_STAGE(PG8_SB(0, 0), cB, voffB); PG8_STAGE(PG8_SB(0, 1), cB + hstep, voffB); PG8_STAGE(PG8_SA(0, 0), cA, voffA); PG8_STAGE(PG8_SA(0, 1), cA + hstep, voffA);
        if (wr == 1) PG8_BAR;
        PG8_WAIT_V(2); PG8_BAR;
        PG8_STAGE(PG8_SB(1, 0), cB + kstep, voffB); PG8_STAGE(PG8_SA(1, 0), cA + kstep, voffA); PG8_STAGE(PG8_SB(1, 1), cB + hstep + kstep, voffB);
        PG8_WAIT_V(6); PG8_BAR;
    } else {
        PG8_STAGE(PG8_SB(0, 0), cB, voffB); PG8_STAGE(PG8_SA(0, 0), cA, voffA); PG8_STAGE(PG8_SB(0, 1), cB + hstep, voffB); PG8_STAGE(PG8_SA(0, 1), cA + hstep, voffA);
        if (wr == 1) PG8_BAR;
        PG8_WAIT_V(4); PG8_BAR;
        PG8_STAGE(PG8_SB(1, 0), cB + kstep, voffB); PG8_STAGE(PG8_SA(1, 0), cA + kstep, voffA); PG8_STAGE(PG8_SB(1, 1), cB + hstep + kstep, voffB);
        PG8_WAIT_V(6); PG8_BAR;
    }
    for (;;) {
        const bool has_next = S.next(ui + 1, nxt);
        const char* nA = has_next ? (const char*)g.A + (size_t)nxt.pm * tstep : cA; const char* nB = has_next ? (const char*)g.Bt + (size_t)nxt.pn * tstep : cB;
        for (int t = 0; t < nt; t += 2) {
            const bool last = (t == nt - 2);
            const char* a1 = cA + (size_t)(t + 1) * kstep;
            const char* a2 = last ? nA : cA + (size_t)(t + 2) * kstep; const char* b2 = last ? nB : cB + (size_t)(t + 2) * kstep;
            const char* a3 = a2 + kstep; const char* b3 = b2 + kstep;
            if (last && has_next) S.a_ready(nxt);
            if constexpr (SP2) {
            PG8_LDB(B0, 0, 0); PG8_LDB(B1, 0, 1); PG8_SCHED; PG8_LDA(At, 0, 0); PG8_STAGE(PG8_SA(1, 1), a1 + hstep, voffA);
            PG8_WAIT_V(8); PG8_WAIT_L(0); PG8_BAR; PG8_MMA(0, 0, At, B0); PG8_MMA(0, 1, At, B1); PG8_BAR; PG8_SCHED;
            PG8_LDA(At, 0, 1); PG8_STAGE(PG8_SB(0, 0), b2, voffB); PG8_STAGE(PG8_SB(0, 1), b2 + hstep, voffB); PG8_STAGE(PG8_SA(0, 0), a2, voffA);
            PG8_WAIT_V(8); PG8_WAIT_L(0); PG8_BAR; PG8_MMA(1, 0, At, B0); PG8_MMA(1, 1, At, B1); PG8_BAR; PG8_SCHED;
            PG8_LDB(B0, 1, 0); PG8_LDB(B1, 1, 1); PG8_SCHED; PG8_LDA(At, 1, 0); PG8_STAGE(PG8_SA(0, 1), a2 + hstep, voffA);
            PG8_WAIT_V(8); PG8_WAIT_L(0); PG8_BAR; PG8_MMA(0, 0, At, B0); PG8_MMA(0, 1, At, B1); PG8_BAR; PG8_SCHED;
            PG8_LDA(At, 1, 1); PG8_STAGE(PG8_SB(1, 0), b3, voffB); PG8_STAGE(PG8_SB(1, 1), b3 + hstep, voffB); PG8_STAGE(PG8_SA(1, 0), a3, voffA);
            PG8_WAIT_V(8); PG8_WAIT_L(0); PG8_BAR; PG8_MMA(1, 0, At, B0); PG8_MMA(1, 1, At, B1); PG8_BAR; PG8_SCHED;
            } else {
            PG8_LDB(B0, 0, 0); PG8_SCHED; PG8_LDA(At, 0, 0); PG8_STAGE(PG8_SA(1, 1), a1 + hstep, voffA);
            PG8_WAIT_L(8); PG8_BAR; PG8_WAIT_L(0); PG8_MMA(0, 0, At, B0); PG8_BAR; PG8_SCHED;
            PG8_LDB(B1, 0, 1); PG8_STAGE(PG8_SB(0, 0), b2, voffB);
            PG8_BAR; PG8_WAIT_L(0); PG8_MMA(0, 1, At, B1); PG8_BAR;
            PG8_LDA(At, 0, 1); PG8_STAGE(PG8_SA(0, 0), a2, voffA);
            PG8_BAR; PG8_WAIT_L(0); PG8_MMA(1, 0, At, B0); PG8_BAR; PG8_SCHED;
            PG8_STAGE(PG8_SB(0, 1), b2 + hstep, voffB);
            PG8_WAIT_V(6); PG8_BAR; PG8_MMA(1, 1, At, B1); PG8_BAR;
            PG8_LDB(B0, 1, 0); PG8_SCHED; PG8_LDA(At, 1, 0); PG8_STAGE(PG8_SA(0, 1), a2 + hstep, voffA);
            PG8_WAIT_L(8); PG8_BAR; PG8_WAIT_L(0); PG8_MMA(0, 0, At, B0); PG8_BAR; PG8_SCHED;
            PG8_LDB(B1, 1, 1); PG8_STAGE(PG8_SB(1, 0), b3, voffB);
            PG8_BAR; PG8_WAIT_L(0); PG8_MMA(0, 1, At, B1); PG8_BAR;
            PG8_LDA(At, 1, 1); PG8_STAGE(PG8_SA(1, 0), a3, voffA);
            PG8_BAR; PG8_WAIT_L(0); PG8_MMA(1, 0, At, B0); PG8_BAR; PG8_SCHED;
            PG8_STAGE(PG8_SB(1, 1), b3 + hstep, voffB);
            PG8_WAIT_V(6); PG8_BAR; PG8_MMA(1, 1, At, B1); PG8_BAR;
            }
        }
        if constexpr (ALIGN_EPI) { if (wr == 0) PG8_BAR; }
        if constexpr (!Epi::AFTER_DRAIN) { E(acc, cur, wr, wc, fr, fq); S.done(cur); }
        if (!has_next) break;
#pragma unroll
        for (int a = 0; a < 2; ++a)
#pragma unroll
            for (int b = 0; b < 2; ++b)
#pragma unroll
                for (int m = 0; m < 4; ++m)
#pragma unroll
                    for (int n = 0; n < 2; ++n) acc[a][b][m][n] = (f32x4){0.f, 0.f, 0.f, 0.f};
        cur = nxt; cA = nA; cB = nB; ++ui;
        if constexpr (ALIGN_EPI) { if (wr == 1) PG8_BAR; }
    }
    PG8_WAIT_V(0);
    if constexpr (!ALIGN_EPI) { if (wr == 0) PG8_BAR; }
    PG8_BAR;
    if constexpr (Epi::AFTER_DRAIN) { E.fused(acc, cur, wr, wc, fr, fq, lds, wid, lane); S.done(cur); }
#undef PG8_SA
#undef PG8_SB
#undef PG8_STAGE
#undef PG8_LDA
#undef PG8_LDB
#undef PG8_MMA
#undef PG8_WAIT_V
#undef PG8_WAIT_L
#undef PG8_BAR
#undef PG8_SCHED
}
}

constexpr int NB = 2, T = 4096, M = NB * T, D = 2048, DIN = 5968, NZ = 6144, PLE = 256;
constexpr int QR = 384, KVR = 256, NQI = 5120;
constexpr int NWAVES = 8, NTHREADS = 512;
constexpr int LDS_BYTES = 155648;
constexpr int RW_WGS = 32;
constexpr size_t MiB = 1u << 20;
constexpr size_t WS_CTL = 0;
constexpr size_t WS_WINT = 1 * MiB;
constexpr size_t WS_WOUTT = 25 * MiB;
constexpr size_t WS_WGATET = 33 * MiB;
constexpr size_t WS_PLEWT = 41 * MiB;
constexpr size_t WS_WQIT = 42 * MiB;
constexpr size_t WS_WUVT = 46 * MiB;
constexpr size_t WS_PBF = 47 * MiB;
constexpr size_t WS_XN = 51 * MiB;
constexpr size_t WS_ZRKV = 83 * MiB;
constexpr size_t WS_GATES = 131 * MiB;
constexpr size_t WS_ZSM = 163 * MiB;
constexpr size_t WS_QLN = 195 * MiB;
constexpr size_t WS_CKV = 201 * MiB;
constexpr size_t WS_KIDX = 205 * MiB;
constexpr size_t WS_WIDX = 206 * MiB;
constexpr size_t WS_QIDX = 207 * MiB;
constexpr size_t WS_PART = 223 * MiB;
constexpr size_t WS_END = 224 * MiB;
constexpr int ZS_WD = 0, ZS_AD = 64, ZS_QL = 128, ZS_KV = 512, ZS_KI = 768, ZS_WI = 832;

#define LAS __attribute__((address_space(3)))
typedef unsigned short bf16;
typedef float f32x4 __attribute__((ext_vector_type(4)));
typedef float f32x16 __attribute__((ext_vector_type(16)));
typedef short bf16x8 __attribute__((ext_vector_type(8)));
typedef short s16x4 __attribute__((ext_vector_type(4)));
typedef unsigned u32x4 __attribute__((ext_vector_type(4)));
typedef unsigned u32x2 __attribute__((ext_vector_type(2)));

__device__ __forceinline__ unsigned f2bf(float f) { unsigned u = __builtin_bit_cast(unsigned, f); return (u + 0x7fffu + ((u >> 16) & 1u)) >> 16; }
__device__ __forceinline__ unsigned pk2(float lo, float hi) { return f2bf(lo) | (f2bf(hi) << 16); }
__device__ __forceinline__ float bflo(unsigned w) { return __builtin_bit_cast(float, w << 16); }
__device__ __forceinline__ float bfhi(unsigned w) { return __builtin_bit_cast(float, w & 0xffff0000u); }
__device__ __forceinline__ float bf1(bf16 v) { return __builtin_bit_cast(float, (unsigned)v << 16); }
template <int CTRL> __device__ __forceinline__ float dppf(float x) { return __builtin_bit_cast(float, __builtin_amdgcn_update_dpp(0, __builtin_bit_cast(int, x), CTRL, 0xF, 0xF, true)); }
__device__ __forceinline__ float allsum8(float x) { x += dppf<0xB1>(x); x += dppf<0x4E>(x); x += dppf<0x141>(x); return x; }
__device__ __forceinline__ float allsum16(float x) { x = allsum8(x); x += dppf<0x140>(x); return x; }
__device__ __forceinline__ float allmax16(float x) { x = fmaxf(x, dppf<0xB1>(x)); x = fmaxf(x, dppf<0x4E>(x)); x = fmaxf(x, dppf<0x141>(x)); x = fmaxf(x, dppf<0x140>(x)); return x; }
__device__ __forceinline__ float wave_sum(float v) {
#pragma unroll
    for (int o = 1; o < 64; o <<= 1) v += __shfl_xor(v, o);
    return v;
}

struct Args { const float* in[26]; float* out; unsigned char* ws; int ph_lo, ph_hi; };
enum { I_X = 0, I_P, I_WIN, I_NORMG, I_MU, I_W0, I_WUP, I_A0, I_AUP, I_KK, I_KA, I_RK, I_LNG, I_LNB, I_QNG, I_KVNG, I_IKNG, I_WUQ, I_WUK, I_WUV, I_IWQ, I_RELB, I_WOUT, I_PLEW, I_WGATE, I_FINALG };

__device__ __forceinline__ int win_src_col(int n) {
    if (n < 3072) return n;
    if (n < 4096) return n - 3072 + 3200;
    if (n < 5120) return n - 4096 + 4944;
    if (n < 5248) return n - 5120 + 3072;
    if (n < 5632) return n - 5248 + 4224;
    if (n < 5888) return n - 5632 + 4608;
    if (n < 5952) return n - 5888 + 4864;
    if (n < 5968) return n - 5952 + 4928;
    return -1;
}
template <bool WIN> __device__ __forceinline__ void transpose_tile(const float* src, int ldsrc, int K, bf16* dst, int nt, int kt, LAS float* scr, int tid) {
    const int n0 = nt * 64, k0 = kt * 64;
    { const int kr = tid >> 4, c4 = (tid & 15) * 4;
      int sc = WIN ? win_src_col(n0 + c4) : (n0 + c4);
#pragma unroll
      for (int pass = 0; pass < 2; ++pass) { const int k = kr + pass * 32;
          f32x4 v = (f32x4){0.f, 0.f, 0.f, 0.f};
          if (sc >= 0) v = *(const f32x4*)(src + (size_t)(k0 + k) * ldsrc + sc);
          scr[k * 65 + c4 + 0] = v[0]; scr[k * 65 + c4 + 1] = v[1]; scr[k * 65 + c4 + 2] = v[2]; scr[k * 65 + c4 + 3] = v[3]; } }
    __syncthreads();
    { const int n = tid >> 3, kq = (tid & 7) * 8; float v[8];
#pragma unroll
      for (int j = 0; j < 8; ++j) v[j] = scr[(kq + j) * 65 + n];
      u32x4 w; w.x = pk2(v[0], v[1]); w.y = pk2(v[2], v[3]); w.z = pk2(v[4], v[5]); w.w = pk2(v[6], v[7]);
      *(u32x4*)(dst + (size_t)(n0 + n) * K + k0 + kq) = w; }
    __syncthreads();
}

__device__ __forceinline__ void phase0(const Args& a, LAS unsigned char* lds) {
    const int tid = threadIdx.x, lane = tid & 63, wave = tid >> 6, G = gridDim.x, bx = blockIdx.x;
    unsigned char* ws = a.ws; LAS float* scr = (LAS float*)lds;
    {   int item = bx;
        const int n_win = (NZ / 64) * (D / 64);
        const int n_sq = (D / 64) * (D / 64);
        const int n_ple = (D / 64) * (PLE / 64);
        const int n_iwq = (1024 / 64) * (QR / 64);
        const int n_wuv = (1024 / 64) * (KVR / 64);
        const int total = n_win + 2 * n_sq + n_ple + n_iwq + n_wuv;
        for (; item < total; item += G) {
            int it = item;
            if (it < n_win) { transpose_tile<true>(a.in[I_WIN], DIN, D, (bf16*)(ws + WS_WINT), it / (D / 64), it % (D / 64), scr, tid); continue; }
            it -= n_win;
            if (it < n_sq) { transpose_tile<false>(a.in[I_WOUT], D, D, (bf16*)(ws + WS_WOUTT), it / (D / 64), it % (D / 64), scr, tid); continue; }
            it -= n_sq;
            if (it < n_sq) { transpose_tile<false>(a.in[I_WGATE], D, D, (bf16*)(ws + WS_WGATET), it / (D / 64), it % (D / 64), scr, tid); continue; }
            it -= n_sq;
            if (it < n_ple) { transpose_tile<false>(a.in[I_PLEW], D, PLE, (bf16*)(ws + WS_PLEWT), it / (PLE / 64), it % (PLE / 64), scr, tid); continue; }
            it -= n_ple;
            if (it < n_iwq) { transpose_tile<false>(a.in[I_IWQ], 1024, QR, (bf16*)(ws + WS_WQIT) + (size_t)4096 * QR, it / (QR / 64), it % (QR / 64), scr, tid); continue; }
            it -= n_iwq;
            transpose_tile<false>(a.in[I_WUV], 1024, KVR, (bf16*)(ws + WS_WUVT), it / (KVR / 64), it % (KVR / 64), scr, tid);
        }
    }
    {   const float* x = a.in[I_X]; const float* g = a.in[I_NORMG]; bf16* xn = (bf16*)(ws + WS_XN);
        for (int row = bx * NWAVES + wave; row < M; row += G * NWAVES) {
            const float* xr = x + (size_t)row * D; f32x4 v[8]; float ss = 0.f;
#pragma unroll
            for (int i = 0; i < 8; ++i) { v[i] = *(const f32x4*)(xr + (i * 64 + lane) * 4); ss += v[i][0] * v[i][0] + v[i][1] * v[i][1] + v[i][2] * v[i][2] + v[i][3] * v[i][3]; }
            ss = wave_sum(ss); const float r = rsqrtf(ss * (1.0f / D) + 1e-6f);
#pragma unroll
            for (int i = 0; i < 8; ++i) { const f32x4 gg = *(const f32x4*)(g + (i * 64 + lane) * 4); u32x2 w; w.x = pk2(v[i][0] * r * gg[0], v[i][1] * r * gg[1]); w.y = pk2(v[i][2] * r * gg[2], v[i][3] * r * gg[3]);
                *(u32x2*)(xn + (size_t)row * D + (i * 64 + lane) * 4) = w; }
        }
    }
    {   const float* p = a.in[I_P]; bf16* pb = (bf16*)(ws + WS_PBF);
        for (int i = bx * NTHREADS + tid; i < M * PLE / 4; i += G * NTHREADS) { const f32x4 v = *(const f32x4*)(p + (size_t)i * 4); u32x2 w; w.x = pk2(v[0], v[1]); w.y = pk2(v[2], v[3]); *(u32x2*)(pb + (size_t)i * 4) = w; }
    }
    {   const float* wuq = a.in[I_WUQ]; const float* wuk = a.in[I_WUK]; bf16* wq = (bf16*)(ws + WS_WQIT);
        for (int item = bx * NTHREADS + tid; item < 4096 * (QR / 8); item += G * NTHREADS) {
            const int n = item / (QR / 8), k8 = (item % (QR / 8)) * 8, h = n >> 8, r = n & 255;
            const float* kr = wuk + (size_t)r * 1024 + h * 64; float accv[8];
#pragma unroll
            for (int j = 0; j < 8; ++j) accv[j] = 0.f;
            for (int d = 0; d < 64; d += 4) { const f32x4 kv = *(const f32x4*)(kr + d);
#pragma unroll
                for (int j = 0; j < 8; ++j) { const f32x4 qv = *(const f32x4*)(wuq + (size_t)(k8 + j) * 1024 + h * 64 + d); accv[j] += qv[0] * kv[0] + qv[1] * kv[1] + qv[2] * kv[2] + qv[3] * kv[3]; } }
            u32x4 w; w.x = pk2(accv[0] * 0.125f, accv[1] * 0.125f); w.y = pk2(accv[2] * 0.125f, accv[3] * 0.125f); w.z = pk2(accv[4] * 0.125f, accv[5] * 0.125f); w.w = pk2(accv[6] * 0.125f, accv[7] * 0.125f);
            *(u32x4*)(wq + (size_t)n * QR + k8) = w;
        }
    }
}

__device__ __forceinline__ void phase2(const Args& a) {
    const int tid = threadIdx.x, lane = tid & 63, wave = tid >> 6, G = gridDim.x, bx = blockIdx.x;
    unsigned char* ws = a.ws; const float* zsm = (const float*)(ws + WS_ZSM);
    bf16* qln = (bf16*)(ws + WS_QLN); bf16* ckv = (bf16*)(ws + WS_CKV); bf16* kidx = (bf16*)(ws + WS_KIDX); float* widx = (float*)(ws + WS_WIDX);
    const float* gq = a.in[I_QNG]; const float* gkv = a.in[I_KVNG]; const float* gik = a.in[I_IKNG];
    for (int row = bx * NWAVES + wave; row < M; row += G * NWAVES) {
        const float* zr = zsm + (size_t)row * 1024;
        { float v[6], ss = 0.f;
#pragma unroll
          for (int i = 0; i < 6; ++i) { v[i] = zr[ZS_QL + i * 64 + lane]; ss += v[i] * v[i]; }
          ss = wave_sum(ss); const float r = rsqrtf(ss * (1.0f / QR) + 1e-6f);
#pragma unroll
          for (int i = 0; i < 6; ++i) qln[(size_t)row * QR + i * 64 + lane] = (bf16)f2bf(v[i] * r * gq[i * 64 + lane]); }
        { const f32x4 v = *(const f32x4*)(zr + ZS_KV + lane * 4); float ss = v[0] * v[0] + v[1] * v[1] + v[2] * v[2] + v[3] * v[3];
          ss = wave_sum(ss); const float r = rsqrtf(ss * (1.0f / KVR) + 1e-6f); const f32x4 gg = *(const f32x4*)(gkv + lane * 4);
          u32x2 w; w.x = pk2(v[0] * r * gg[0], v[1] * r * gg[1]); w.y = pk2(v[2] * r * gg[2], v[3] * r * gg[3]); *(u32x2*)(ckv + (size_t)row * KVR + lane * 4) = w; }
        { const float v = zr[ZS_KI + lane]; float ss = wave_sum(v * v); const float r = rsqrtf(ss * (1.0f / 64) + 1e-6f);
          kidx[(size_t)row * 64 + lane] = (bf16)f2bf(v * r * gik[lane]); }
        if (lane < 16) widx[(size_t)row * 16 + lane] = zr[ZS_WI + lane] * (1.0f / 32.0f);
    }
}

constexpr int RW_TC = 32;
__device__ __forceinline__ float softplus_f(float x) { return fmaxf(x, 0.f) + log1pf(expf(-fabsf(x))); }
__device__ __forceinline__ void rwkv_unit(const Args& a, LAS unsigned char* lds, int b, int h) {
    const int tid = threadIdx.x;
    unsigned char* ws = a.ws;
    const bf16* zrkv = (const bf16*)(ws + WS_ZRKV); const float* zsm = (const float*)(ws + WS_ZSM); const bf16* gates = (const bf16*)(ws + WS_GATES); bf16* mixed = (bf16*)(ws + WS_XN);
    LAS float* Wup = (LAS float*)(lds); LAS float* Aup = (LAS float*)(lds + 16384);
    LAS float* WD = (LAS float*)(lds + 32768); LAS float* AD = (LAS float*)(lds + 40960); LAS float* Y = WD;
    LAS float* Aa = (LAS float*)(lds + 49152); LAS float* WR = (LAS float*)(lds + 57344); LAS float* Wd = (LAS float*)(lds + 65536);
    LAS float* Bb = (LAS float*)(lds + 73728); LAS float* Kp = (LAS float*)(lds + 81920); LAS float* Vv = (LAS float*)(lds + 90112);
    LAS float* SBR = (LAS float*)(lds + 98304); LAS float* SKR = SBR + 32; LAS float* SBC = SBR + 64;
    for (int i = tid; i < 64 * 16; i += NTHREADS) { const int r = i >> 4, c4 = (i & 15) * 4;
        *(LAS f32x4*)(Wup + r * 64 + c4) = *(const f32x4*)(a.in[I_WUP] + (size_t)r * 1024 + h * 64 + c4);
        *(LAS f32x4*)(Aup + r * 64 + c4) = *(const f32x4*)(a.in[I_AUP] + (size_t)r * 1024 + h * 64 + c4); }
    const int pt = tid >> 4, c4 = (tid & 15) * 4, ch = h * 64 + c4;
    const f32x4 mu_r = *(const f32x4*)(a.in[I_MU] + ch), mu_k = *(const f32x4*)(a.in[I_MU] + 1024 + ch), mu_v = *(const f32x4*)(a.in[I_MU] + 2048 + ch);
    const f32x4 mu_wd = *(const f32x4*)(a.in[I_MU] + 3072 + c4), mu_ad = *(const f32x4*)(a.in[I_MU] + 3136 + c4);
    const f32x4 w0 = *(const f32x4*)(a.in[I_W0] + ch), a0 = *(const f32x4*)(a.in[I_A0] + ch), k_k = *(const f32x4*)(a.in[I_KK] + ch), k_a = *(const f32x4*)(a.in[I_KA] + ch);
    const f32x4 r_k = *(const f32x4*)(a.in[I_RK] + ch), ln_g = *(const f32x4*)(a.in[I_LNG] + ch), ln_b = *(const f32x4*)(a.in[I_LNB] + ch);
    const int sr = tid >> 3, c8 = (tid & 7) * 8;
    float s[8];
#pragma unroll
    for (int j = 0; j < 8; ++j) s[j] = 0.f;
    __syncthreads();
    for (int ck = 0; ck < T / RW_TC; ++ck) {
        const int tpos = ck * RW_TC + pt; const size_t tok = (size_t)b * T + tpos;
        f32x4 rs, ks, vs;
        {
            const bf16* zr = zrkv + tok * 3072 + ch;
            const u32x2 r2 = *(const u32x2*)(zr), k2 = *(const u32x2*)(zr + 1024), v2 = *(const u32x2*)(zr + 2048);
            u32x2 rp = (u32x2){0u, 0u}, kp = rp, vp = rp; f32x4 wdp = (f32x4){0.f, 0.f, 0.f, 0.f}, adp = wdp;
            const f32x4 wdc = *(const f32x4*)(zsm + tok * 1024 + ZS_WD + c4), adc = *(const f32x4*)(zsm + tok * 1024 + ZS_AD + c4);
            if (tpos > 0) { rp = *(const u32x2*)(zr - 3072); kp = *(const u32x2*)(zr - 3072 + 1024); vp = *(const u32x2*)(zr - 3072 + 2048);
                wdp = *(const f32x4*)(zsm + (tok - 1) * 1024 + ZS_WD + c4); adp = *(const f32x4*)(zsm + (tok - 1) * 1024 + ZS_AD + c4); }
            const f32x4 rc = (f32x4){bflo(r2.x), bfhi(r2.x), bflo(r2.y), bfhi(r2.y)}, rq = (f32x4){bflo(rp.x), bfhi(rp.x), bflo(rp.y), bfhi(rp.y)};
            const f32x4 kc = (f32x4){bflo(k2.x), bfhi(k2.x), bflo(k2.y), bfhi(k2.y)}, kq = (f32x4){bflo(kp.x), bfhi(kp.x), bflo(kp.y), bfhi(kp.y)};
            const f32x4 vc = (f32x4){bflo(v2.x), bfhi(v2.x), bflo(v2.y), bfhi(v2.y)}, vq = (f32x4){bflo(vp.x), bfhi(vp.x), bflo(vp.y), bfhi(vp.y)};
            rs = rc + mu_r * (rq - rc); ks = kc + mu_k * (kq - kc); vs = vc + mu_v * (vq - vc);
            const f32x4 wds = wdc + mu_wd * (wdp - wdc), ads = adc + mu_ad * (adp - adc);
            f32x4 tw; tw[0] = tanhf(wds[0]); tw[1] = tanhf(wds[1]); tw[2] = tanhf(wds[2]); tw[3] = tanhf(wds[3]);
            *(LAS f32x4*)(WD + pt * 64 + c4) = tw; *(LAS f32x4*)(AD + pt * 64 + c4) = ads;
        }
        __syncthreads();
        {
            f32x4 wp = w0, ap = a0;
            for (int i = 0; i < 64; ++i) { const float xw = WD[pt * 64 + i], xa = AD[pt * 64 + i];
                const f32x4 wu = *(LAS f32x4*)(Wup + i * 64 + c4), au = *(LAS f32x4*)(Aup + i * 64 + c4);
                wp += xw * wu; ap += xa * au; }
            f32x4 dec, av, kk, kp2, wr; float n2 = 0.f;
#pragma unroll
            for (int j = 0; j < 4; ++j) { const float wl = -softplus_f(-wp[j]) - 0.5f; dec[j] = expf(-expf(wl)); av[j] = 1.0f / (1.0f + expf(-ap[j]));
                kk[j] = ks[j] * k_k[j]; n2 += kk[j] * kk[j]; }
            n2 = allsum16(n2); const float inv = 1.0f / fmaxf(sqrtf(n2), 1e-12f);
            float br = 0.f, kr = 0.f, bc = 0.f; f32x4 aa, bb;
#pragma unroll
            for (int j = 0; j < 4; ++j) { kk[j] *= inv; kp2[j] = ks[j] * (1.0f + (av[j] - 1.0f) * k_a[j]); aa[j] = -kk[j]; bb[j] = kk[j] * av[j]; wr[j] = dec[j] * rs[j];
                br += bb[j] * rs[j]; kr += kp2[j] * rs[j]; bc += rs[j] * kp2[j] * r_k[j]; }
            br = allsum16(br); kr = allsum16(kr); bc = allsum16(bc);
            *(LAS f32x4*)(Aa + pt * 64 + c4) = aa; *(LAS f32x4*)(WR + pt * 64 + c4) = wr; *(LAS f32x4*)(Wd + pt * 64 + c4) = dec;
            *(LAS f32x4*)(Bb + pt * 64 + c4) = bb; *(LAS f32x4*)(Kp + pt * 64 + c4) = kp2; *(LAS f32x4*)(Vv + pt * 64 + c4) = vs;
            if ((tid & 15) == 0) { SBR[pt] = br; SKR[pt] = kr; SBC[pt] = bc; }
        }
        __syncthreads();
#pragma unroll 2
        for (int tt = 0; tt < RW_TC; ++tt) {
            const f32x4 a0v = *(LAS f32x4*)(Aa + tt * 64 + c8), a1v = *(LAS f32x4*)(Aa + tt * 64 + c8 + 4);
            const f32x4 q0v = *(LAS f32x4*)(WR + tt * 64 + c8), q1v = *(LAS f32x4*)(WR + tt * 64 + c8 + 4);
            const f32x4 w0v = *(LAS f32x4*)(Wd + tt * 64 + c8), w1v = *(LAS f32x4*)(Wd + tt * 64 + c8 + 4);
            const f32x4 b0v = *(LAS f32x4*)(Bb + tt * 64 + c8), b1v = *(LAS f32x4*)(Bb + tt * 64 + c8 + 4);
            const f32x4 k0v = *(LAS f32x4*)(Kp + tt * 64 + c8), k1v = *(LAS f32x4*)(Kp + tt * 64 + c8 + 4);
            const float vt = Vv[tt * 64 + sr], brt = SBR[tt], krt = SKR[tt];
            float d1 = 0.f, d2 = 0.f;
#pragma unroll
            for (int j = 0; j < 4; ++j) { d1 += s[j] * a0v[j] + s[4 + j] * a1v[j]; d2 += s[j] * q0v[j] + s[4 + j] * q1v[j]; }
            d1 = allsum8(d1); d2 = allsum8(d2);
            const float y = d2 + d1 * brt + vt * krt;
#pragma unroll
            for (int j = 0; j < 4; ++j) { s[j] = s[j] * w0v[j] + d1 * b0v[j] + vt * k0v[j]; s[4 + j] = s[4 + j] * w1v[j] + d1 * b1v[j] + vt * k1v[j]; }
            if ((tid & 7) == 0) Y[tt * 64 + sr] = y;
        }
        __syncthreads();
        {
            const f32x4 yv = *(LAS f32x4*)(Y + pt * 64 + c4);
            const float mean = allsum16(yv[0] + yv[1] + yv[2] + yv[3]) * (1.0f / 64.0f);
            const f32x4 dv = yv - mean;
            const float var = allsum16(dv[0] * dv[0] + dv[1] * dv[1] + dv[2] * dv[2] + dv[3] * dv[3]) * (1.0f / 64.0f);
            const float rstd = rsqrtf(var + 64e-5f), bcf = SBC[pt];
            const u32x2 g2 = *(const u32x2*)(gates + tok * 2048 + ch);
            const f32x4 gv = (f32x4){bflo(g2.x), bfhi(g2.x), bflo(g2.y), bfhi(g2.y)};
            f32x4 o;
#pragma unroll
            for (int j = 0; j < 4; ++j) o[j] = (dv[j] * rstd * ln_g[j] + ln_b[j] + bcf * vs[j]) * gv[j];
            u32x2 w; w.x = pk2(o[0], o[1]); w.y = pk2(o[2], o[3]);
            *(u32x2*)(mixed + tok * 2048 + ch) = w;
        }
        __syncthreads();
    }
}

constexpr int CS_PITCH = 528;
constexpr int DSA_SEL = 135168, DSA_PB = 139264, DSA_BIAS = 147712, DSA_XCH = 149760;
__device__ __forceinline__ unsigned fkey(float x) { const unsigned u = __builtin_bit_cast(unsigned, x); return (u & 0x80000000u) ? ~u : (u | 0x80000000u); }
__device__ __forceinline__ int mbcnt64(unsigned long long m) { return __builtin_amdgcn_mbcnt_hi((unsigned)(m >> 32), __builtin_amdgcn_mbcnt_lo((unsigned)m, 0u)); }
__device__ __forceinline__ int t5_bucket(int rel) {
    const int n = rel < 0 ? -rel : rel; int r = rel > 0 ? 16 : 0;
    if (n < 8) return r + n;
    int large = 2 + (31 - __clz(n * n)); if (large > 15) large = 15;
    return r + large;
}
__device__ __forceinline__ void dsa_unit(const Args& a, LAS unsigned char* lds, int b, int qg) {
    const int tid = threadIdx.x, lane = tid & 63, w = __builtin_amdgcn_readfirstlane(tid >> 6);
    unsigned char* ws = a.ws;
    const bf16* qidx = (const bf16*)(ws + WS_QIDX); const bf16* kidx = (const bf16*)(ws + WS_KIDX); const float* widx = (const float*)(ws + WS_WIDX);
    const bf16* ckv = (const bf16*)(ws + WS_CKV); bf16* qabs = (bf16*)a.out;
    LAS float* SC = (LAS float*)lds; LAS unsigned char* CS = lds;
    LAS unsigned short* SEL = (LAS unsigned short*)(lds + DSA_SEL); LAS unsigned char* PB = lds + DSA_PB;
    LAS float* BIAS = (LAS float*)(lds + DSA_BIAS); LAS float* XCH = (LAS float*)(lds + DSA_XCH);
    const int q0 = qg * 8, L = ((q0 >> 6) + 1) * 64, nk = L < 256 ? L : 256;
    const size_t tok0 = (size_t)b * T + q0, kb = (size_t)b * T;
    BIAS[tid] = a.in[I_RELB][tid];
    if (L > 256) {
        const int rb = w & 3, kh = w >> 2, i = lane & 31, half = lane >> 5;
        const int ql = 2 * rb + ((i >> 2) & 1), head = (i & 3) | ((i >> 3) << 2);
        bf16x8 af[4];
#pragma unroll
        for (int ks = 0; ks < 4; ++ks) af[ks] = *(const bf16x8*)(qidx + (tok0 + ql) * 1024 + head * 64 + ks * 16 + half * 8);
        const int qo = 2 * rb + half; float wq[16];
#pragma unroll
        for (int j = 0; j < 4; ++j) { const f32x4 v = *(const f32x4*)(widx + (tok0 + qo) * 16 + j * 4); wq[j * 4 + 0] = v[0]; wq[j * 4 + 1] = v[1]; wq[j * 4 + 2] = v[2]; wq[j * 4 + 3] = v[3]; }
        for (int kt = kh; kt < L / 32; kt += 2) {
            const int key = kt * 32 + i; const bf16* kp = kidx + (kb + key) * 64 + half * 8;
            f32x16 acc;
#pragma unroll
            for (int j = 0; j < 16; ++j) acc[j] = 0.f;
#pragma unroll
            for (int ks = 0; ks < 4; ++ks) { const bf16x8 bfr = *(const bf16x8*)(kp + ks * 16); acc = __builtin_amdgcn_mfma_f32_32x32x16_bf16(af[ks], bfr, acc, 0, 0, 0); }
            float sc = 0.f;
#pragma unroll
            for (int j = 0; j < 16; ++j) sc += wq[j] * fmaxf(acc[j], 0.f);
            SC[qo * 4096 + key] = sc;
        }
    }
    __syncthreads();
    if (L <= 256) {
        for (int j = lane; j < 256; j += 64) SEL[w * 256 + j] = (unsigned short)j;
    } else {
        const int nreg = L / 64; unsigned u[64];
#pragma unroll
        for (int j = 0; j < 64; ++j) u[j] = (j < nreg) ? fkey(SC[w * 4096 + j * 64 + lane]) : 0u;
        unsigned thr = 0u;
        for (int bit = 31; bit >= 0; --bit) { const unsigned cand = thr | (1u << bit); int cnt = 0;
#pragma unroll
            for (int j = 0; j < 64; ++j) if (j < nreg) cnt += __popcll(__ballot(u[j] >= cand));
            if (cnt >= 256) thr = cand; }
        int ngt = 0;
#pragma unroll
        for (int j = 0; j < 64; ++j) if (j < nreg) ngt += __popcll(__ballot(u[j] > thr));
        int ties_left = 256 - ngt, pos = 0;
#pragma unroll
        for (int j = 0; j < 64; ++j) if (j < nreg) {
            const bool gt = u[j] > thr, eq = u[j] == thr;
            const unsigned long long em = __ballot(eq);
            const bool take = gt || (eq && mbcnt64(em) < ties_left);
            const unsigned long long tm = __ballot(take);
            if (take) SEL[w * 256 + pos + mbcnt64(tm)] = (unsigned short)(j * 64 + lane);
            pos += __popcll(tm); const int ne = __popcll(em); ties_left -= (ne < ties_left ? ne : ties_left);
        }
    }
    __syncthreads();
    const int fr = lane & 15, hq = lane >> 4;
    for (int jq = 0; jq < 8; ++jq) {
        const int qpos = q0 + jq; const size_t tok = tok0 + jq;
        const bool active = (32 * w < nk);
        if (active) {
#pragma unroll 4
            for (int it = 0; it < 16; ++it) { const int kl = 32 * w + 2 * it + (lane >> 5); const int idx = SEL[jq * 256 + kl];
                const u32x4 v = *(const u32x4*)(ckv + (kb + idx) * KVR + (lane & 31) * 8);
                *(LAS u32x4*)(CS + kl * CS_PITCH + (lane & 31) * 16) = v; }
        }
        bf16x8 aq[8];
#pragma unroll
        for (int ks = 0; ks < 8; ++ks) aq[ks] = *(const bf16x8*)(qabs + tok * 4096 + fr * 256 + ks * 32 + hq * 8);
        __syncthreads();
        f32x4 sv[2]; float gmax[4];
        if (active) {
#pragma unroll
            for (int j = 0; j < 2; ++j) { f32x4 acc = (f32x4){0.f, 0.f, 0.f, 0.f};
#pragma unroll
                for (int ks = 0; ks < 8; ++ks) { const bf16x8 bfr = *(LAS bf16x8*)(CS + (32 * w + 16 * j + fr) * CS_PITCH + (ks * 32 + hq * 8) * 2); acc = __builtin_amdgcn_mfma_f32_16x16x32_bf16(aq[ks], bfr, acc, 0, 0, 0); }
                const int kidxv = SEL[jq * 256 + 32 * w + 16 * j + fr]; const int bk = t5_bucket(kidxv - qpos);
                const f32x4 bv = *(LAS f32x4*)(BIAS + bk * 16 + hq * 4);
                sv[j] = acc + bv; }
#pragma unroll
            for (int r = 0; r < 4; ++r) { const float m = allmax16(fmaxf(sv[0][r], sv[1][r])); if (fr == 0) XCH[w * 16 + hq * 4 + r] = m; }
        } else if (fr == 0) {
#pragma unroll
            for (int r = 0; r < 4; ++r) XCH[w * 16 + hq * 4 + r] = -3.0e38f;
        }
        __syncthreads();
#pragma unroll
        for (int r = 0; r < 4; ++r) gmax[r] = -3.0e38f;
#pragma unroll
        for (int ww = 0; ww < 8; ++ww) { const f32x4 m = *(LAS f32x4*)(XCH + ww * 16 + hq * 4);
#pragma unroll
            for (int r = 0; r < 4; ++r) gmax[r] = fmaxf(gmax[r], m[r]); }
        if (active) {
#pragma unroll
            for (int r = 0; r < 4; ++r) { const float p0 = __expf(sv[0][r] - gmax[r]), p1 = __expf(sv[1][r] - gmax[r]);
                const float ps = allsum16(p0 + p1); if (fr == 0) XCH[128 + w * 16 + hq * 4 + r] = ps;
                *(LAS unsigned short*)(PB + (hq * 4 + r) * CS_PITCH + (32 * w + fr) * 2) = (unsigned short)f2bf(p0);
                *(LAS unsigned short*)(PB + (hq * 4 + r) * CS_PITCH + (32 * w + 16 + fr) * 2) = (unsigned short)f2bf(p1); }
        } else if (fr == 0) {
#pragma unroll
            for (int r = 0; r < 4; ++r) XCH[128 + w * 16 + hq * 4 + r] = 0.f;
        }
        __syncthreads();
        {
            f32x4 o0 = (f32x4){0.f, 0.f, 0.f, 0.f}, o1 = o0;
            const int g = lane >> 4, qq = (lane & 15) >> 2, pp = lane & 3;
            for (int ks = 0; ks < nk / 32; ++ks) {
                const bf16x8 pa = *(LAS bf16x8*)(PB + fr * CS_PITCH + (ks * 32 + hq * 8) * 2);
                LAS unsigned char* base = CS + (ks * 32 + 8 * g + qq) * CS_PITCH + (32 * w + 4 * pp) * 2;
                const s16x4 b00 = __builtin_amdgcn_ds_read_tr16_b64_v4i16((LAS s16x4*)(base));
                const s16x4 b01 = __builtin_amdgcn_ds_read_tr16_b64_v4i16((LAS s16x4*)(base + 4 * CS_PITCH));
                const s16x4 b10 = __builtin_amdgcn_ds_read_tr16_b64_v4i16((LAS s16x4*)(base + 32));
                const s16x4 b11 = __builtin_amdgcn_ds_read_tr16_b64_v4i16((LAS s16x4*)(base + 32 + 4 * CS_PITCH));
                const bf16x8 bf0 = (bf16x8){b00[0], b00[1], b00[2], b00[3], b01[0], b01[1], b01[2], b01[3]};
                const bf16x8 bf1 = (bf16x8){b10[0], b10[1], b10[2], b10[3], b11[0], b11[1], b11[2], b11[3]};
                o0 = __builtin_amdgcn_mfma_f32_16x16x32_bf16(pa, bf0, o0, 0, 0, 0);
                o1 = __builtin_amdgcn_mfma_f32_16x16x32_bf16(pa, bf1, o1, 0, 0, 0);
            }
            float ls[4];
#pragma unroll
            for (int r = 0; r < 4; ++r) ls[r] = 0.f;
#pragma unroll
            for (int ww = 0; ww < 8; ++ww) { const f32x4 m = *(LAS f32x4*)(XCH + 128 + ww * 16 + hq * 4);
#pragma unroll
                for (int r = 0; r < 4; ++r) ls[r] += m[r]; }
#pragma unroll
            for (int r = 0; r < 4; ++r) { const float inv = 1.0f / ls[r]; bf16* op = qabs + tok * 4096 + (hq * 4 + r) * 256 + 32 * w + fr;
                op[0] = (bf16)f2bf(o0[r] * inv); op[16] = (bf16)f2bf(o1[r] * inv); }
        }
        __syncthreads();
    }
}

__device__ __forceinline__ void uv_unit(const Args& a, int tt, int h) {
    const int tid = threadIdx.x, lane = tid & 63, w = tid >> 6, mt = w & 3, nt = w >> 2, i = lane & 31, half = lane >> 5;
    unsigned char* ws = a.ws; const bf16* ol = (const bf16*)a.out; const bf16* wuvt = (const bf16*)(ws + WS_WUVT); const bf16* gates = (const bf16*)(ws + WS_GATES); bf16* mixed = (bf16*)(ws + WS_XN);
    const size_t row = (size_t)tt * 128 + mt * 32 + i;
    const bf16* ap = ol + row * 4096 + h * 256 + half * 8; const bf16* bp = wuvt + (size_t)(h * 64 + nt * 32 + i) * KVR + half * 8;
    f32x16 acc;
#pragma unroll
    for (int j = 0; j < 16; ++j) acc[j] = 0.f;
#pragma unroll 4
    for (int ks = 0; ks < 16; ++ks) { const bf16x8 av = *(const bf16x8*)(ap + ks * 16), bv = *(const bf16x8*)(bp + ks * 16); acc = __builtin_amdgcn_mfma_f32_32x32x16_bf16(av, bv, acc, 0, 0, 0); }
    const int col = h * 64 + nt * 32 + i;
#pragma unroll
    for (int r = 0; r < 16; ++r) { const size_t orow = (size_t)tt * 128 + mt * 32 + (r & 3) + 8 * (r >> 2) + 4 * half;
        const float gv = bf1(gates[orow * 2048 + 1024 + col]); mixed[orow * 2048 + 1024 + col] = (bf16)f2bf(acc[r] * gv); }
}

__device__ __forceinline__ void phase8(const Args& a) {
    const int tid = threadIdx.x, lane = tid & 63, wave = tid >> 6, G = gridDim.x, bx = blockIdx.x;
    const float* part = (const float*)(a.ws + WS_PART); const float* g = a.in[I_FINALG]; float* out = a.out;
    for (int row = bx * NWAVES + wave; row < M; row += G * NWAVES) {
        float ss = (lane < 32) ? part[(size_t)row * 32 + lane] : 0.f; ss = wave_sum(ss);
        const float r = rsqrtf(ss * (1.0f / D) + 1e-6f); float* orow = out + (size_t)row * D;
#pragma unroll
        for (int i = 0; i < 8; ++i) { const int c = (i * 64 + lane) * 4; f32x4 v = *(const f32x4*)(orow + c); const f32x4 gg = *(const f32x4*)(g + c);
            v[0] = v[0] * r * gg[0]; v[1] = v[1] * r * gg[1]; v[2] = v[2] * r * gg[2]; v[3] = v[3] * r * gg[3]; *(f32x4*)(orow + c) = v; }
    }
}

__global__ void __launch_bounds__(NTHREADS, 2) mega_fwd(Args a) {
    extern __shared__ __attribute__((aligned(16))) unsigned char lds_raw[];
    LAS unsigned char* lds = (LAS unsigned char*)lds_raw;
    cg::grid_group grid = cg::this_grid();
    unsigned char* ws = a.ws; const int G = gridDim.x, bx = blockIdx.x;
    const int lo = a.ph_lo, hi = a.ph_hi;
#define IN(k) (lo <= (k) && (k) < hi)
#define SEAM(k) do { if (IN((k) + 1)) grid.sync(); } while (0)
    if (IN(0)) { phase0(a, lds); SEAM(0); }
    if (IN(1)) {
        pg8::Gemm g{(const pg8::bf16_t*)(ws + WS_XN), (const pg8::bf16_t*)(ws + WS_WINT), M, NZ, D}; pg8::StaticOrder S; S.init(M, NZ, G, bx);
        pg8::EpiZ E{(pg8::bf16_t*)(ws + WS_ZRKV), (pg8::bf16_t*)(ws + WS_GATES), (float*)(ws + WS_ZSM)};
        pg8::gemm_phase<pg8::EpiZ, pg8::StaticOrder, true, true>(lds, g, S, E);
        SEAM(1);
    }
    if (IN(2)) { phase2(a); SEAM(2); }
    if (IN(3)) {
        pg8::Gemm g{(const pg8::bf16_t*)(ws + WS_QLN), (const pg8::bf16_t*)(ws + WS_WQIT), M, NQI, QR}; pg8::StaticOrder S; S.init(M, NQI, G, bx);
        pg8::EpiBf16Split E{(pg8::bf16_t*)a.out, 4096, 16, (pg8::bf16_t*)(ws + WS_QIDX), 1024};
        pg8::gemm_phase<pg8::EpiBf16Split, pg8::StaticOrder, true, true>(lds, g, S, E);
        SEAM(3);
    }
    if (IN(4)) {
        if (bx < RW_WGS) { rwkv_unit(a, lds, bx >> 4, bx & 15); }
        else { for (int u = bx - RW_WGS; u < 1024; u += G - RW_WGS) dsa_unit(a, lds, u & 1, 511 - (u >> 1)); }
        SEAM(4);
    }
    if (IN(5)) { for (int u = bx; u < 1024; u += G) uv_unit(a, u >> 4, u & 15); SEAM(5); }
    if (IN(6)) {
        {   pg8::Gemm g{(const pg8::bf16_t*)(ws + WS_XN), (const pg8::bf16_t*)(ws + WS_WOUTT), M, D, D}; pg8::StaticOrder S; S.init(M, D, G, bx);
            pg8::EpiH E{a.in[I_X], a.out, (pg8::bf16_t*)(ws + WS_ZRKV)};
            pg8::gemm_phase<pg8::EpiH, pg8::StaticOrder, true, true>(lds, g, S, E); }
        {   pg8::Gemm g{(const pg8::bf16_t*)(ws + WS_PBF), (const pg8::bf16_t*)(ws + WS_PLEWT), M, D, PLE}; pg8::StaticOrder S; S.init(M, D, G, bx);
            pg8::EpiBf16Split E{(pg8::bf16_t*)(ws + WS_GATES), 2048, 8, (pg8::bf16_t*)(ws + WS_GATES), 2048};
            pg8::gemm_phase<pg8::EpiBf16Split, pg8::StaticOrder, true, true>(lds, g, S, E); }
        SEAM(6);
    }
    if (IN(7)) {
        pg8::Gemm g{(const pg8::bf16_t*)(ws + WS_ZRKV), (const pg8::bf16_t*)(ws + WS_WGATET), M, D, D}; pg8::StaticOrder S; S.init(M, D, G, bx);
        pg8::EpiOut E{a.out, (const pg8::bf16_t*)(ws + WS_GATES), (float*)(ws + WS_PART)};
        pg8::gemm_phase<pg8::EpiOut, pg8::StaticOrder, true, true>(lds, g, S, E);
        SEAM(7);
    }
    if (IN(8)) phase8(a);
}

#ifndef N_LAUNCHES
#define N_LAUNCHES 1
#endif
extern "C" void kernel_launch(void* const* d_in, const int* in_sizes, int n_in, void* d_out, int out_size, void* d_ws, size_t ws_size, hipStream_t stream) {
    static int grid = 0;
    if (grid == 0) {
        int dev = 0, cus = 0, per_cu = 0;
        if (n_in != 26 || out_size != M * D || ws_size < WS_END) { fprintf(stderr, "kernel_launch: unexpected shapes (n_in %d out %d ws %zu)\n", n_in, out_size, ws_size); grid = -1; return; }
        (void)hipGetDevice(&dev); (void)hipDeviceGetAttribute(&cus, hipDeviceAttributeMultiprocessorCount, dev);
        if (hipFuncSetAttribute((const void*)mega_fwd, hipFuncAttributeMaxDynamicSharedMemorySize, LDS_BYTES) != hipSuccess) { fprintf(stderr, "kernel_launch: hipFuncSetAttribute failed\n"); grid = -1; return; }
        if (hipOccupancyMaxActiveBlocksPerMultiprocessor(&per_cu, (const void*)mega_fwd, NTHREADS, LDS_BYTES) != hipSuccess || per_cu < 1) { fprintf(stderr, "kernel_launch: occupancy query says %d\n", per_cu); grid = -1; return; }
        grid = cus;
        fprintf(stderr, "kernel_launch: cus %d per_cu %d grid %d\n", cus, per_cu, grid);
    }
    if (grid < 0) return;
    Args a{};
    for (int i = 0; i < 26; ++i) a.in[i] = (const float*)d_in[i];
    a.out = (float*)d_out; a.ws = (unsigned char*)d_ws;
    const int NPH = 9;
    for (int li = 0; li < N_LAUNCHES; ++li) {
        a.ph_lo = (N_LAUNCHES == 1) ? 0 : li; a.ph_hi = (N_LAUNCHES == 1) ? NPH : li + 1;
        void* args[] = {&a};
        const hipError_t e = hipLaunchCooperativeKernel((const void*)mega_fwd, dim3(grid), dim3(NTHREADS), args, LDS_BYTES, stream);
        if (e != hipSuccess) { fprintf(stderr, "kernel_launch: cooperative launch failed: %s (grid %d)\n", hipGetErrorString(e), grid); break; }
    }
}
```

```cpp
#include <hip/hip_runtime.h>
#include <hip/hip_cooperative_groups.h>
#include <cstdio>
#include <cstdint>
namespace cg = cooperative_groups;
#ifndef PROBE_DUP
#define PROBE_DUP 0
#endif

namespace pg8 {
#define PG8_LAS __attribute__((address_space(3)))
typedef unsigned short bf16_t;
typedef short bf16x8 __attribute__((ext_vector_type(8)));
typedef float f32x4 __attribute__((ext_vector_type(4)));
typedef unsigned u32x4 __attribute__((ext_vector_type(4)));
constexpr int BM = 256, BK = 64, HALF = 128, HTB = HALF * BK * 2  , STAGE_BYTES = 8 * HTB, NXCD = 8, WGM = 8;

__host__ __device__ __forceinline__ int lds_byte(int r, int c) { const int st = (r >> 4) * 2 + (c >> 5), rr = r & 15, cc = c & 31, ob = rr * 64 + cc * 2; return st * 1024 + (ob ^ (((ob >> 9) & 1) << 5)); }
__host__ __device__ __forceinline__ void stage_rc(int b, int& R, int& C) { const int st = b / 1024, sb = b % 1024, swz = sb ^ (((sb >> 9) & 1) << 5); R = (st >> 1) * 16 + swz / 64; C = (st & 1) * 32 + (swz % 64) / 2; }
__host__ __device__ __forceinline__ int perm32(int rho) { const int n = rho >> 4, i = rho & 15; return 8 * (i >> 2) + 4 * n + (i & 3); }

struct Unit { int pm, pn; };
struct Gemm { const bf16_t* A; const bf16_t* Bt; int M, N, K; };

struct StaticOrder {
    int nM, nN, nwg, G, c;
    __host__ __device__ void init(int M, int N, int G_, int c_) { nM = M / BM; nN = N / BM; nwg = nM * nN; G = G_; c = c_; }
    __host__ __device__ bool next(int i, Unit& u) const {
        const long L = (long)i * G + c; if (L >= nwg) return false;
        int wgid = (int)L; { const int q = nwg / NXCD, r = nwg % NXCD, xcd = wgid % NXCD, off = wgid / NXCD; wgid = (xcd < r ? xcd * (q + 1) : r * (q + 1) + (xcd - r) * q) + off; }
        const int nig = WGM * nN, gid = wgid / nig, fm = gid * WGM, gsz = (nM - fm) < WGM ? (nM - fm) : WGM;
        u.pm = fm + ((wgid % nig) % gsz); u.pn = (wgid % nig) / gsz; return true;
    }
    __device__ __forceinline__ void a_ready(const Unit&) const {}
    __device__ __forceinline__ void done(const Unit&) const {}
};

typedef float f32x2v_t __attribute__((ext_vector_type(2)));
typedef __bf16 bf16x2v_t __attribute__((ext_vector_type(2)));
__device__ __forceinline__ unsigned cvt_pk_bf16(float lo, float hi) { const f32x2v_t v = {lo, hi}; const bf16x2v_t b = __builtin_convertvector(v, bf16x2v_t); return __builtin_bit_cast(unsigned, b); }
__device__ __forceinline__ float silu_f(float v) { return v / (1.0f + __expf(-v)); }
__device__ __forceinline__ float sigmoid_f(float v) { return 1.0f / (1.0f + __expf(-v)); }
__device__ __forceinline__ u32x4 pack8(const f32x4& v0, const f32x4& v1) { u32x4 w; w.x = cvt_pk_bf16(v0[0], v0[1]); w.y = cvt_pk_bf16(v0[2], v0[3]); w.z = cvt_pk_bf16(v1[0], v1[1]); w.w = cvt_pk_bf16(v1[2], v1[3]); return w; }

struct EpiZ {
    static constexpr bool PERM = true, AFTER_DRAIN = false;
    bf16_t* zrkv; bf16_t* gates; float* zsm;
    __device__ __forceinline__ void operator()(const f32x4 (&acc)[2][2][4][2], const Unit& u, int wr, int wc, int fr, int fq) const {
        const int row0 = u.pm * BM + wr * 64 + fr, colw = wc * 32 + 8 * fq;
        if (u.pn < 12) {
#pragma unroll
            for (int ai = 0; ai < 2; ++ai)
#pragma unroll
                for (int m = 0; m < 4; ++m) { bf16_t* rowp = zrkv + (size_t)(row0 + ai * HALF + m * 16) * 3072 + u.pn * BM + colw;
#pragma unroll
                    for (int bj = 0; bj < 2; ++bj) *(u32x4*)(rowp + bj * HALF) = pack8(acc[ai][bj][m][0], acc[ai][bj][m][1]); }
        } else if (u.pn < 20) {
#pragma unroll
            for (int ai = 0; ai < 2; ++ai)
#pragma unroll
                for (int m = 0; m < 4; ++m) { bf16_t* rowp = gates + (size_t)(row0 + ai * HALF + m * 16) * 2048 + (u.pn - 12) * BM + colw;
#pragma unroll
                    for (int bj = 0; bj < 2; ++bj) { f32x4 v0 = acc[ai][bj][m][0], v1 = acc[ai][bj][m][1];
#pragma unroll
                        for (int j = 0; j < 4; ++j) { v0[j] = silu_f(v0[j]); v1[j] = silu_f(v1[j]); }
                        *(u32x4*)(rowp + bj * HALF) = pack8(v0, v1); } }
        } else {
#pragma unroll
            for (int ai = 0; ai < 2; ++ai)
#pragma unroll
                for (int m = 0; m < 4; ++m) { float* rowp = zsm + (size_t)(row0 + ai * HALF + m * 16) * 1024 + (u.pn - 20) * BM + colw;
#pragma unroll
                    for (int bj = 0; bj < 2; ++bj) { *(f32x4*)(rowp + bj * HALF) = acc[ai][bj][m][0]; *(f32x4*)(rowp + bj * HALF + 4) = acc[ai][bj][m][1]; } }
        }
    }
};
struct EpiBf16Split {
    static constexpr bool PERM = true, AFTER_DRAIN = false;
    bf16_t* O0; int ld0; int nt0; bf16_t* O1; int ld1;
    __device__ __forceinline__ void operator()(const f32x4 (&acc)[2][2][4][2], const Unit& u, int wr, int wc, int fr, int fq) const {
        const int row0 = u.pm * BM + wr * 64 + fr, colw = wc * 32 + 8 * fq;
        bf16_t* base; int ld, ct;
        if (u.pn < nt0) { base = O0; ld = ld0; ct = u.pn; } else { base = O1; ld = ld1; ct = u.pn - nt0; }
#pragma unroll
        for (int ai = 0; ai < 2; ++ai)
#pragma unroll
            for (int m = 0; m < 4; ++m) { bf16_t* rowp = base + (size_t)(row0 + ai * HALF + m * 16) * ld + ct * BM + colw;
#pragma unroll
                for (int bj = 0; bj < 2; ++bj) *(u32x4*)(rowp + bj * HALF) = pack8(acc[ai][bj][m][0], acc[ai][bj][m][1]); }
    }
};
struct EpiH {
    static constexpr bool PERM = true, AFTER_DRAIN = false;
    const float* x; float* h; bf16_t* hb;
    __device__ __forceinline__ void operator()(const f32x4 (&acc)[2][2][4][2], const Unit& u, int wr, int wc, int fr, int fq) const {
        const int row0 = u.pm * BM + wr * 64 + fr, col0 = u.pn * BM + wc * 32 + 8 * fq;
#pragma unroll
        for (int ai = 0; ai < 2; ++ai)
#pragma unroll
            for (int m = 0; m < 4; ++m) { const size_t ro = (size_t)(row0 + ai * HALF + m * 16) * 2048 + col0;
#pragma unroll
                for (int bj = 0; bj < 2; ++bj) { const size_t o = ro + bj * HALF;
                    const f32x4 v0 = acc[ai][bj][m][0] + *(const f32x4*)(x + o), v1 = acc[ai][bj][m][1] + *(const f32x4*)(x + o + 4);
                    *(f32x4*)(h + o) = v0; *(f32x4*)(h + o + 4) = v1; *(u32x4*)(hb + o) = pack8(v0, v1); } }
    }
};
struct EpiOut {
    static constexpr bool PERM = true, AFTER_DRAIN = false;
    float* h; const bf16_t* ple; float* part;
    __device__ __forceinline__ void operator()(const f32x4 (&acc)[2][2][4][2], const Unit& u, int wr, int wc, int fr, int fq) const {
        const int row0 = u.pm * BM + wr * 64 + fr, col0 = u.pn * BM + wc * 32 + 8 * fq;
#pragma unroll
        for (int ai = 0; ai < 2; ++ai)
#pragma unroll
            for (int m = 0; m < 4; ++m) { const int row = row0 + ai * HALF + m * 16; const size_t ro = (size_t)row * 2048 + col0; float ss = 0.f;
#pragma unroll
                for (int bj = 0; bj < 2; ++bj) { const size_t o = ro + bj * HALF;
                    const u32x4 pw = *(const u32x4*)(ple + o);
                    f32x4 p0, p1; p0[0] = __builtin_bit_cast(float, pw.x << 16); p0[1] = __builtin_bit_cast(float, pw.x & 0xffff0000u); p0[2] = __builtin_bit_cast(float, pw.y << 16); p0[3] = __builtin_bit_cast(float, pw.y & 0xffff0000u);
                    p1[0] = __builtin_bit_cast(float, pw.z << 16); p1[1] = __builtin_bit_cast(float, pw.z & 0xffff0000u); p1[2] = __builtin_bit_cast(float, pw.w << 16); p1[3] = __builtin_bit_cast(float, pw.w & 0xffff0000u);
                    f32x4 v0 = *(const f32x4*)(h + o), v1 = *(const f32x4*)(h + o + 4);
#pragma unroll
                    for (int j = 0; j < 4; ++j) { v0[j] += p0[j] * sigmoid_f(acc[ai][bj][m][0][j]); v1[j] += p1[j] * sigmoid_f(acc[ai][bj][m][1][j]); ss += v0[j] * v0[j] + v1[j] * v1[j]; }
                    *(f32x4*)(h + o) = v0; *(f32x4*)(h + o + 4) = v1; }
                ss += __shfl_xor(ss, 16); ss += __shfl_xor(ss, 32);
                if (fq == 0) part[(size_t)row * 32 + u.pn * 4 + wc] = ss; }
    }
};

template <class Epi, class Sched, bool ALIGN_EPI = false, bool SP2 = false>
__device__ __forceinline__ void gemm_phase(PG8_LAS unsigned char* lds, const Gemm g, const Sched& S, const Epi& E) {
    const int tid = threadIdx.x, wid = __builtin_amdgcn_readfirstlane(tid >> 6), lane = tid & 63, wr = wid >> 2, wc = wid & 3, fr = lane & 15, fq = lane >> 4;
    const int K = g.K, nt = K / BK;
    unsigned voffA[2], voffB[2];
#pragma unroll
    for (int i = 0; i < 2; ++i) { int R, C; stage_rc(tid * 16 + i * 8192, R, C); const int Rb = Epi::PERM ? ((R & ~31) + perm32(R & 31)) : R;
        voffA[i] = (unsigned)(R * K + C) * 2u; voffB[i] = (unsigned)(Rb * K + C) * 2u; }
    const size_t kstep = (size_t)(BK * 2);
    const size_t hstep = (size_t)HALF * K * 2;
    const size_t tstep = 2 * hstep;
    const unsigned ldsw = (unsigned)wid * 1024u;
    const int aoff = lds_byte(wr * 64 + fr, fq * 8), boff = lds_byte(wc * 32 + fr, fq * 8);
#define PG8_SA(b, h) (((b) * 2 + (h)) * HTB)
#define PG8_SB(b, h) ((4 + (b) * 2 + (h)) * HTB)
#define PG8_STAGE(bufoff, gbase, voff) do { _Pragma("unroll") for (int _i = 0; _i < 2; ++_i) \
        __builtin_amdgcn_global_load_lds((const unsigned*)((const char*)(gbase) + (voff)[_i]), (PG8_LAS unsigned*)(lds + (bufoff) + ldsw + _i * 8192), 16, 0, 0); } while (0)
#define PG8_LDA(dst, b, h) do { _Pragma("unroll") for (int m = 0; m < 4; ++m) _Pragma("unroll") for (int k = 0; k < 2; ++k) dst[m][k] = *(const PG8_LAS bf16x8*)(lds + PG8_SA(b, h) + aoff + m * 2048 + k * 1024); } while (0)
#define PG8_LDB(dst, b, h) do { _Pragma("unroll") for (int n = 0; n < 2; ++n) _Pragma("unroll") for (int k = 0; k < 2; ++k) dst[n][k] = *(const PG8_LAS bf16x8*)(lds + PG8_SB(b, h) + boff + n * 2048 + k * 1024); } while (0)
#define PG8_MMA(ai, bj, At, Bt) do { __builtin_amdgcn_s_setprio(1); _Pragma("unroll") for (int m = 0; m < 4; ++m) _Pragma("unroll") for (int n = 0; n < 2; ++n) _Pragma("unroll") for (int k = 0; k < 2; ++k) \
        acc[ai][bj][m][n] = __builtin_amdgcn_mfma_f32_16x16x32_bf16(Bt[n][k], At[m][k], acc[ai][bj][m][n], 0, 0, 0); __builtin_amdgcn_s_setprio(0); } while (0)
#define PG8_WAIT_V(n) asm volatile("s_waitcnt vmcnt(" #n ")" ::: "memory")
#define PG8_WAIT_L(n) asm volatile("s_waitcnt lgkmcnt(" #n ")" ::: "memory")
#define PG8_BAR __builtin_amdgcn_s_barrier()
#define PG8_SCHED __builtin_amdgcn_sched_barrier(0)
    Unit cur, nxt; int ui = 0;
    if (!S.next(0, cur)) return;
    f32x4 acc[2][2][4][2];
#pragma unroll
    for (int a = 0; a < 2; ++a)
#pragma unroll
        for (int b = 0; b < 2; ++b)
#pragma unroll
            for (int m = 0; m < 4; ++m)
#pragma unroll
                for (int n = 0; n < 2; ++n) acc[a][b][m][n] = (f32x4){0.f, 0.f, 0.f, 0.f};
    bf16x8 At[4][2], B0[2][2], B1[2][2];
    const char* cA = (const char*)g.A + (size_t)cur.pm * tstep; const char* cB = (const char*)g.Bt + (size_t)cur.pn * tstep;
    S.a_ready(cur);
    if constexpr (SP2) {
        PG8_STAGE(PG8_SB(0, 0), cB, voffB); PG8_STAGE(PG8_SB(0, 1), cB + hstep, voffB); PG8_STAGE(PG8_SA(0, 0), cA, voffA); PG8_STAGE(PG8_SA(0, 1), cA + hstep, voffA);
        if (wr == 1) PG8_BAR;
        PG8_WAIT_V(2); PG8_BAR;
        PG8_STAGE(PG8_SB(1, 0), cB + kstep, voffB); PG8_STAGE(PG8_SA(1, 0), cA + kstep, voffA); PG8_STAGE(PG8_SB(1, 1), cB + hstep + kstep, voffB);
        PG8_WAIT_V(6); PG8_BAR;
    } else {
        PG8_STAGE(PG8_SB(0, 0), cB, voffB); PG8_STAGE(PG8_SA(0, 0), cA, voffA); PG8_STAGE(PG8_SB(0, 1), cB + hstep, voffB); PG8_STAGE(PG8_SA(0, 1), cA + hstep, voffA);
        if (wr == 1) PG8_BAR;
        PG8_WAIT_V(4); PG8_BAR;
        PG8_STAGE(PG8_SB(1, 0), cB + kstep, voffB); PG8_STAGE(PG8_SA(1, 0), cA + kstep, voffA); PG8_STAGE(PG8_SB(1, 1), cB + hstep + kstep, voffB);
        PG8_WAIT_V(6); PG8_BAR;
    }
    for (;;) {
        const bool has_next = S.next(ui + 1, nxt);
        const char* nA = has_next ? (const char*)g.A + (size_t)nxt.pm * tstep : cA; const char* nB = has_next ? (const char*)g.Bt + (size_t)nxt.pn * tstep : cB;
        for (int t = 0; t < nt; t += 2) {
            const bool last = (t == nt - 2);
            const char* a1 = cA + (size_t)(t + 1) * kstep;
            const char* a2 = last ? nA : cA + (size_t)(t + 2) * kstep; const char* b2 = last ? nB : cB + (size_t)(t + 2) * kstep;
            const char* a3 = a2 + kstep; const char* b3 = b2 + kstep;
            if (last && has_next) S.a_ready(nxt);
            if constexpr (SP2) {
            PG8_LDB(B0, 0, 0); PG8_LDB(B1, 0, 1); PG8_SCHED; PG8_LDA(At, 0, 0); PG8_STAGE(PG8_SA(1, 1), a1 + hstep, voffA);
            PG8_WAIT_V(8); PG8_WAIT_L(0); PG8_BAR; PG8_MMA(0, 0, At, B0); PG8_MMA(0, 1, At, B1); PG8_BAR; PG8_SCHED;
            PG8_LDA(At, 0, 1); PG8_STAGE(PG8_SB(0, 0), b2, voffB); PG8_STAGE(PG8_SB(0, 1), b2 + hstep, voffB); PG8_STAGE(PG8_SA(0, 0), a2, voffA);
            PG8_WAIT_V(8); PG8_WAIT_L(0); PG8_BAR; PG8_MMA(1, 0, At, B0); PG8_MMA(1, 1, At, B1); PG8_BAR; PG8_SCHED;
            PG8_LDB(B0, 1, 0); PG8_LDB(B1, 1, 1); PG8_SCHED; PG8_LDA(At, 1, 0); PG8_STAGE(PG8_SA(0, 1), a2 + hstep, voffA);
            PG8_WAIT_V(8); PG8_WAIT_L(0); PG8_BAR; PG8_MMA(0, 0, At, B0); PG8_MMA(0, 1, At, B1); PG8_BAR; PG8_SCHED;
            PG8_LDA(At, 1, 1); PG8_STAGE(PG8_SB(1, 0), b3, voffB); PG8_STAGE(PG8_SB(1, 1), b3 + hstep, voffB); PG8_STAGE(PG8_SA(1, 0), a3, voffA);
            PG8_WAIT_V(8); PG8_WAIT_L(0); PG8_BAR; PG8_MMA(1, 0, At, B0); PG8_MMA(1, 1, At, B1); PG8_BAR; PG8_SCHED;
            } else {
            PG8_LDB(B0, 0, 0); PG8_SCHED; PG8_LDA(At, 0, 0); PG8_STAGE(PG8_SA(1, 1), a1 + hstep, voffA);
            PG8_WAIT_L(8); PG8_BAR; PG8_WAIT_L(0); PG8_MMA(0, 0, At, B0); PG8_BAR; PG8_SCHED;
            PG8_LDB(B1, 0, 1); PG8_STAGE(PG8_SB(0, 0), b2, voffB);
            PG8_BAR; PG8_WAIT_L(0); PG8_MMA(0, 1, At, B1); PG8_BAR;
            PG8_LDA(At, 0, 1); PG8_STAGE(PG8_SA(0, 0), a2, voffA);
            PG8_BAR; PG8_WAIT_L(0); PG8_MMA(1, 0, At, B0); PG8_BAR; PG8_SCHED;
            PG8_STAGE(PG8_SB(0, 1), b2 + hstep, voffB);
            PG8_WAIT_V(6); PG8_BAR; PG8_MMA(1, 1, At, B1); PG8_BAR;
            PG8_LDB(B0, 1, 0); PG8_SCHED; PG8_LDA(At, 1, 0); PG8_STAGE(PG8_SA(0, 1), a2 + hstep, voffA);
            PG8_WAIT_L(8); PG8_BAR; PG8_WAIT_L(0); PG8_MMA(0, 0, At, B0); PG8_BAR; PG8_SCHED;
            PG8_LDB(B1, 1, 1); PG8_STAGE(PG8_SB(1, 0), b3, voffB);
            PG8_BAR; PG8_WAIT_L(0); PG8_MMA(0, 1, At, B1); PG8_BAR;
            PG8_LDA(At, 1, 1); PG8_STAGE(PG8_SA(1, 0), a3, voffA);
            PG8_BAR; PG8_WAIT_L(0); PG8_MMA(1, 0, At, B0); PG8_BAR; PG8_SCHED;
            PG8_STAGE(PG8_SB(1, 1), b3 + hstep, voffB);
            PG8_WAIT_V(6); PG8_BAR; PG8_MMA(1, 1, At, B1); PG8_BAR;
            }
        }
        if constexpr (ALIGN_EPI) { if (wr == 0) PG8_BAR; }
        if constexpr (!Epi::AFTER_DRAIN) { E(acc, cur, wr, wc, fr, fq); S.done(cur); }
        if (!has_next) break;
#pragma unroll
        for (int a = 0; a < 2; ++a)
#pragma unroll
            for (int b = 0; b < 2; ++b)
#pragma unroll
                for (int m = 0; m < 4; ++m)
#pragma unroll
                    for (int n = 0; n < 2; ++n) acc[a][b][m][n] = (f32x4){0.f, 0.f, 0.f, 0.f};
        cur = nxt; cA = nA; cB = nB; ++ui;
        if constexpr (ALIGN_EPI) { if (wr == 1) PG8_BAR; }
    }
    PG8_WAIT_V(0);
    if constexpr (!ALIGN_EPI) { if (wr == 0) PG8_BAR; }
    PG8_BAR;
    if constexpr (Epi::AFTER_DRAIN) { E.fused(acc, cur, wr, wc, fr, fq, lds, wid, lane); S.done(cur); }
#undef PG8_SA
#undef PG8_SB
#undef PG8_STAGE
#undef PG8_LDA
#undef PG8_LDB
#undef PG8_MMA
#undef PG8_WAIT_V
#undef PG8_WAIT_L
#undef PG8_BAR
#undef PG8_SCHED
}
}

constexpr int NB = 2, T = 4096, M = NB * T, D = 2048, DIN = 5968, NZ = 6144, PLE = 256;
constexpr int QR = 384, KVR = 256, NQI = 5120;
constexpr int NWAVES = 8, NTHREADS = 512;
constexpr int LDS_BYTES = 155648;
constexpr int RW_WGS = 32;
constexpr size_t MiB = 1u << 20;
constexpr size_t WS_CTL = 0;
constexpr size_t WS_WINT = 1 * MiB;
constexpr size_t WS_WOUTT = 25 * MiB;
constexpr size_t WS_WGATET = 33 * MiB;
constexpr size_t WS_PLEWT = 41 * MiB;
constexpr size_t WS_WQIT = 42 * MiB;
constexpr size_t WS_WUVT = 46 * MiB;
constexpr size_t WS_PBF = 47 * MiB;
constexpr size_t WS_XN = 51 * MiB;
constexpr size_t WS_ZRKV = 83 * MiB;
constexpr size_t WS_GATES = 131 * MiB;
constexpr size_t WS_ZSM = 163 * MiB;
constexpr size_t WS_QLN = 195 * MiB;
constexpr size_t WS_CKV = 201 * MiB;
constexpr size_t WS_KIDX = 205 * MiB;
constexpr size_t WS_WIDX = 206 * MiB;
constexpr size_t WS_QIDX = 207 * MiB;
constexpr size_t WS_PART = 223 * MiB;
constexpr size_t WS_END = 224 * MiB;
constexpr int ZS_WD = 0, ZS_AD = 64, ZS_QL = 128, ZS_KV = 512, ZS_KI = 768, ZS_WI = 832;

#define LAS __attribute__((address_space(3)))
typedef unsigned short bf16;
typedef float f32x4 __attribute__((ext_vector_type(4)));
typedef float f32x16 __attribute__((ext_vector_type(16)));
typedef short bf16x8 __attribute__((ext_vector_type(8)));
typedef short s16x4 __attribute__((ext_vector_type(4)));
typedef unsigned u32x4 __attribute__((ext_vector_type(4)));
typedef unsigned u32x2 __attribute__((ext_vector_type(2)));

__device__ __forceinline__ unsigned f2bf(float f) { unsigned u = __builtin_bit_cast(unsigned, f); return (u + 0x7fffu + ((u >> 16) & 1u)) >> 16; }
typedef float f32x2_t __attribute__((ext_vector_type(2)));
typedef __bf16 bf16x2_t __attribute__((ext_vector_type(2)));
__device__ __forceinline__ unsigned pk2(float lo, float hi) { const f32x2_t v = {lo, hi}; const bf16x2_t b = __builtin_convertvector(v, bf16x2_t); return __builtin_bit_cast(unsigned, b); }
__device__ __forceinline__ float bflo(unsigned w) { return __builtin_bit_cast(float, w << 16); }
__device__ __forceinline__ float bfhi(unsigned w) { return __builtin_bit_cast(float, w & 0xffff0000u); }
__device__ __forceinline__ float bf1(bf16 v) { return __builtin_bit_cast(float, (unsigned)v << 16); }
template <int CTRL> __device__ __forceinline__ float dppf(float x) { return __builtin_bit_cast(float, __builtin_amdgcn_update_dpp(0, __builtin_bit_cast(int, x), CTRL, 0xF, 0xF, true)); }
__device__ __forceinline__ float allsum8(float x) { x += dppf<0xB1>(x); x += dppf<0x4E>(x); x += dppf<0x141>(x); return x; }
__device__ __forceinline__ float allsum16(float x) { x = allsum8(x); x += dppf<0x140>(x); return x; }
__device__ __forceinline__ float allmax16(float x) { x = fmaxf(x, dppf<0xB1>(x)); x = fmaxf(x, dppf<0x4E>(x)); x = fmaxf(x, dppf<0x141>(x)); x = fmaxf(x, dppf<0x140>(x)); return x; }
__device__ __forceinline__ float wave_sum(float v) {
#pragma unroll
    for (int o = 1; o < 64; o <<= 1) v += __shfl_xor(v, o);
    return v;
}

struct Args { const float* in[26]; float* out; unsigned char* ws; int ph_lo, ph_hi; };
enum { I_X = 0, I_P, I_WIN, I_NORMG, I_MU, I_W0, I_WUP, I_A0, I_AUP, I_KK, I_KA, I_RK, I_LNG, I_LNB, I_QNG, I_KVNG, I_IKNG, I_WUQ, I_WUK, I_WUV, I_IWQ, I_RELB, I_WOUT, I_PLEW, I_WGATE, I_FINALG };

__device__ __forceinline__ int win_src_col(int n) {
    if (n < 3072) return n;
    if (n < 4096) return n - 3072 + 3200;
    if (n < 5120) return n - 4096 + 4944;
    if (n < 5248) return n - 5120 + 3072;
    if (n < 5632) return n - 5248 + 4224;
    if (n < 5888) return n - 5632 + 4608;
    if (n < 5952) return n - 5888 + 4864;
    if (n < 5968) return n - 5952 + 4928;
    return -1;
}
template <bool WIN> __device__ __forceinline__ void transpose_tile(const float* src, int ldsrc, int K, bf16* dst, int nt, int kt, LAS float* scr, int tid) {
    const int n0 = nt * 64, k0 = kt * 64;
    { const int kr = tid >> 4, c4 = (tid & 15) * 4;
      int sc = WIN ? win_src_col(n0 + c4) : (n0 + c4);
#pragma unroll
      for (int pass = 0; pass < 2; ++pass) { const int k = kr + pass * 32;
          f32x4 v = (f32x4){0.f, 0.f, 0.f, 0.f};
          if (sc >= 0) v = *(const f32x4*)(src + (size_t)(k0 + k) * ldsrc + sc);
          scr[k * 65 + c4 + 0] = v[0]; scr[k * 65 + c4 + 1] = v[1]; scr[k * 65 + c4 + 2] = v[2]; scr[k * 65 + c4 + 3] = v[3]; } }
    __syncthreads();
    { const int n = tid >> 3, kq = (tid & 7) * 8; float v[8];
#pragma unroll
      for (int j = 0; j < 8; ++j) v[j] = scr[(kq + j) * 65 + n];
      u32x4 w; w.x = pk2(v[0], v[1]); w.y = pk2(v[2], v[3]); w.z = pk2(v[4], v[5]); w.w = pk2(v[6], v[7]);
      *(u32x4*)(dst + (size_t)(n0 + n) * K + k0 + kq) = w; }
    __syncthreads();
}

__device__ __forceinline__ void phase0(const Args& a, LAS unsigned char* lds) {
    const int tid = threadIdx.x, lane = tid & 63, wave = tid >> 6, G = gridDim.x, bx = blockIdx.x;
    unsigned char* ws = a.ws; LAS float* scr = (LAS float*)lds;
    {   int item = bx;
        const int n_win = (NZ / 64) * (D / 64);
        const int n_sq = (D / 64) * (D / 64);
        const int n_ple = (D / 64) * (PLE / 64);
        const int n_iwq = (1024 / 64) * (QR / 64);
        const int n_wuv = (1024 / 64) * (KVR / 64);
        const int total = n_win + 2 * n_sq + n_ple + n_iwq + n_wuv;
        for (; item < total; item += G) {
            int it = item;
            if (it < n_win) { transpose_tile<true>(a.in[I_WIN], DIN, D, (bf16*)(ws + WS_WINT), it / (D / 64), it % (D / 64), scr, tid); continue; }
            it -= n_win;
            if (it < n_sq) { transpose_tile<false>(a.in[I_WOUT], D, D, (bf16*)(ws + WS_WOUTT), it / (D / 64), it % (D / 64), scr, tid); continue; }
            it -= n_sq;
            if (it < n_sq) { transpose_tile<false>(a.in[I_WGATE], D, D, (bf16*)(ws + WS_WGATET), it / (D / 64), it % (D / 64), scr, tid); continue; }
            it -= n_sq;
            if (it < n_ple) { transpose_tile<false>(a.in[I_PLEW], D, PLE, (bf16*)(ws + WS_PLEWT), it / (PLE / 64), it % (PLE / 64), scr, tid); continue; }
            it -= n_ple;
            if (it < n_iwq) { transpose_tile<false>(a.in[I_IWQ], 1024, QR, (bf16*)(ws + WS_WQIT) + (size_t)4096 * QR, it / (QR / 64), it % (QR / 64), scr, tid); continue; }
            it -= n_iwq;
            transpose_tile<false>(a.in[I_WUV], 1024, KVR, (bf16*)(ws + WS_WUVT), it / (KVR / 64), it % (KVR / 64), scr, tid);
        }
    }
    {   const float* x = a.in[I_X]; const float* g = a.in[I_NORMG]; bf16* xn = (bf16*)(ws + WS_XN);
        for (int row = bx * NWAVES + wave; row < M; row += G * NWAVES) {
            const float* xr = x + (size_t)row * D; f32x4 v[8]; float ss = 0.f;
#pragma unroll
            for (int i = 0; i < 8; ++i) { v[i] = *(const f32x4*)(xr + (i * 64 + lane) * 4); ss += v[i][0] * v[i][0] + v[i][1] * v[i][1] + v[i][2] * v[i][2] + v[i][3] * v[i][3]; }
            ss = wave_sum(ss); const float r = rsqrtf(ss * (1.0f / D) + 1e-6f);
#pragma unroll
            for (int i = 0; i < 8; ++i) { const f32x4 gg = *(const f32x4*)(g + (i * 64 + lane) * 4); u32x2 w; w.x = pk2(v[i][0] * r * gg[0], v[i][1] * r * gg[1]); w.y = pk2(v[i][2] * r * gg[2], v[i][3] * r * gg[3]);
                *(u32x2*)(xn + (size_t)row * D + (i * 64 + lane) * 4) = w; }
        }
    }
    {   const float* p = a.in[I_P]; bf16* pb = (bf16*)(ws + WS_PBF);
        for (int i = bx * NTHREADS + tid; i < M * PLE / 4; i += G * NTHREADS) { const f32x4 v = *(const f32x4*)(p + (size_t)i * 4); u32x2 w; w.x = pk2(v[0], v[1]); w.y = pk2(v[2], v[3]); *(u32x2*)(pb + (size_t)i * 4) = w; }
    }
    {   const float* wuq = a.in[I_WUQ]; const float* wuk = a.in[I_WUK]; bf16* wq = (bf16*)(ws + WS_WQIT);
        for (int item = bx * NTHREADS + tid; item < 4096 * (QR / 8); item += G * NTHREADS) {
            const int n = item / (QR / 8), k8 = (item % (QR / 8)) * 8, h = n >> 8, r = n & 255;
            const float* kr = wuk + (size_t)r * 1024 + h * 64; float accv[8];
#pragma unroll
            for (int j = 0; j < 8; ++j) accv[j] = 0.f;
            for (int d = 0; d < 64; d += 4) { const f32x4 kv = *(const f32x4*)(kr + d);
#pragma unroll
                for (int j = 0; j < 8; ++j) { const f32x4 qv = *(const f32x4*)(wuq + (size_t)(k8 + j) * 1024 + h * 64 + d); accv[j] += qv[0] * kv[0] + qv[1] * kv[1] + qv[2] * kv[2] + qv[3] * kv[3]; } }
            u32x4 w; w.x = pk2(accv[0] * 0.125f, accv[1] * 0.125f); w.y = pk2(accv[2] * 0.125f, accv[3] * 0.125f); w.z = pk2(accv[4] * 0.125f, accv[5] * 0.125f); w.w = pk2(accv[6] * 0.125f, accv[7] * 0.125f);
            *(u32x4*)(wq + (size_t)n * QR + k8) = w;
        }
    }
}

__device__ __forceinline__ void phase2(const Args& a) {
    const int tid = threadIdx.x, lane = tid & 63, wave = tid >> 6, G = gridDim.x, bx = blockIdx.x;
    unsigned char* ws = a.ws; const float* zsm = (const float*)(ws + WS_ZSM);
    bf16* qln = (bf16*)(ws + WS_QLN); bf16* ckv = (bf16*)(ws + WS_CKV); bf16* kidx = (bf16*)(ws + WS_KIDX); float* widx = (float*)(ws + WS_WIDX);
    const float* gq = a.in[I_QNG]; const float* gkv = a.in[I_KVNG]; const float* gik = a.in[I_IKNG];
    for (int row = bx * NWAVES + wave; row < M; row += G * NWAVES) {
        const float* zr = zsm + (size_t)row * 1024;
        { float v[6], ss = 0.f;
#pragma unroll
          for (int i = 0; i < 6; ++i) { v[i] = zr[ZS_QL + i * 64 + lane]; ss += v[i] * v[i]; }
          ss = wave_sum(ss); const float r = rsqrtf(ss * (1.0f / QR) + 1e-6f);
#pragma unroll
          for (int i = 0; i < 6; ++i) qln[(size_t)row * QR + i * 64 + lane] = (bf16)f2bf(v[i] * r * gq[i * 64 + lane]); }
        { const f32x4 v = *(const f32x4*)(zr + ZS_KV + lane * 4); float ss = v[0] * v[0] + v[1] * v[1] + v[2] * v[2] + v[3] * v[3];
          ss = wave_sum(ss); const float r = rsqrtf(ss * (1.0f / KVR) + 1e-6f); const f32x4 gg = *(const f32x4*)(gkv + lane * 4);
          u32x2 w; w.x = pk2(v[0] * r * gg[0], v[1] * r * gg[1]); w.y = pk2(v[2] * r * gg[2], v[3] * r * gg[3]); *(u32x2*)(ckv + (size_t)row * KVR + lane * 4) = w; }
        { const float v = zr[ZS_KI + lane]; float ss = wave_sum(v * v); const float r = rsqrtf(ss * (1.0f / 64) + 1e-6f);
          kidx[(size_t)row * 64 + lane] = (bf16)f2bf(v * r * gik[lane]); }
        if (lane < 16) widx[(size_t)row * 16 + lane] = zr[ZS_WI + lane] * (1.0f / 32.0f);
    }
}

constexpr int RC_WUP = 0, RC_AUP = 9216, RC_S0 = 18432, RC_AT = 27648, RC_RT = 36864, RC_BT = 46080, RC_KT = 55296, RC_VT = 64512, RC_XA = 73728, RC_XB = 82944, RC_TA = 92160, RC_TB = 101376,
              RC_MAK = 110592, RC_NRB = 119808, RC_NRK = 129024, RC_VEC = 138240, RC_CST = 139008;
constexpr int RC_WPRE = RC_XA, RC_APRE = RC_TA, RC_LW = RC_MAK, RC_TOT = RC_NRK, RC_WDT = RC_AT, RC_ADT = RC_RT, RC_YF = RC_XA;
constexpr int MP = 144, FP = 272;
__device__ __forceinline__ float softplus_f(float x) { return fmaxf(x, 0.f) + __logf(1.0f + __expf(-fabsf(x))); }
__device__ __forceinline__ float tanh_fast(float x) { const float e = __expf(2.0f * x); return 1.0f - 2.0f * __builtin_amdgcn_rcpf(1.0f + e); }
__device__ __forceinline__ bf16x8 ld_contig(LAS const unsigned char* Mx, int row, int k0) { return *(LAS const bf16x8*)(Mx + row * MP + k0 * 2); }
__device__ __forceinline__ bf16x8 ld_tr(LAS const unsigned char* Mx, int krow0, int col0, int q, int p) {
    LAS const unsigned char* base = Mx + (krow0 + q) * MP + (col0 + 4 * p) * 2;
    const s16x4 lo = __builtin_amdgcn_ds_read_tr16_b64_v4i16((LAS s16x4*)(base));
    const s16x4 hi = __builtin_amdgcn_ds_read_tr16_b64_v4i16((LAS s16x4*)(base + 4 * MP));
    return (bf16x8){lo[0], lo[1], lo[2], lo[3], hi[0], hi[1], hi[2], hi[3]};
}
template <bool A_TR, bool B_TR> __device__ __forceinline__ void mm_acc(f32x16& acc, LAS const unsigned char* A, LAS const unsigned char* B, int rb, int cb, int lane) {
    const int l31 = lane & 31, kh = lane >> 5, q = (lane & 15) >> 2, p = lane & 3, cblk = ((lane >> 4) & 1) * 16;
#pragma unroll
    for (int ks = 0; ks < 4; ++ks) { const int k0 = ks * 16 + 8 * kh;
        const bf16x8 qf = A_TR ? ld_tr(A, k0, 32 * rb + cblk, q, p) : ld_contig(A, 32 * rb + l31, k0);
        const bf16x8 pf = B_TR ? ld_tr(B, k0, 32 * cb + cblk, q, p) : ld_contig(B, 32 * cb + l31, k0);
        acc = __builtin_amdgcn_mfma_f32_32x32x16_bf16(pf, qf, acc, 0, 0, 0); }
}
__device__ __forceinline__ void st_tile_bf16(LAS unsigned char* Dm, const f32x16& acc, int rb, int cb, int lane) {
    LAS unsigned char* rowp = Dm + (32 * rb + (lane & 31)) * MP + (32 * cb + 4 * (lane >> 5)) * 2;
#pragma unroll
    for (int g = 0; g < 4; ++g) { u32x2 w; w.x = pk2(acc[4 * g], acc[4 * g + 1]); w.y = pk2(acc[4 * g + 2], acc[4 * g + 3]); *(LAS u32x2*)(rowp + 16 * g) = w; }
}
__device__ __forceinline__ void st_tile_f32(LAS unsigned char* Dm, const f32x16& acc, int rb, int cb, int lane) {
    LAS unsigned char* rowp = Dm + (32 * rb + (lane & 31)) * FP + (32 * cb + 4 * (lane >> 5)) * 4;
#pragma unroll
    for (int g = 0; g < 4; ++g) *(LAS f32x4*)(rowp + 32 * g) = (f32x4){acc[4 * g], acc[4 * g + 1], acc[4 * g + 2], acc[4 * g + 3]};
}
template <bool INCL> __device__ __forceinline__ void mask_tril(f32x16& acc, int rb, int cb, int lane) {
    const int row = 32 * rb + (lane & 31);
#pragma unroll
    for (int j = 0; j < 16; ++j) { const int col = 32 * cb + (j & 3) + 8 * (j >> 2) + 4 * (lane >> 5); if (INCL ? (col > row) : (col >= row)) acc[j] = 0.f; }
}
__device__ __forceinline__ f32x16 zero16() { f32x16 z;
#pragma unroll
    for (int j = 0; j < 16; ++j) z[j] = 0.f;
    return z; }

__device__ __forceinline__ void rwkv_unit(const Args& a, LAS unsigned char* lds, int b, int h) {
    const int tid = threadIdx.x, lane = tid & 63, w = __builtin_amdgcn_readfirstlane(tid >> 6);
    unsigned char* ws = a.ws;
    const bf16* zrkv = (const bf16*)(ws + WS_ZRKV); const float* zsm = (const float*)(ws + WS_ZSM); const bf16* gates = (const bf16*)(ws + WS_GATES); bf16* mixed = (bf16*)(ws + WS_XN);
    for (int i = tid; i < 64 * 8; i += NTHREADS) { const int r = i >> 3, c = (i & 7) * 8;
        const f32x4 w0v = *(const f32x4*)(a.in[I_WUP] + (size_t)r * 1024 + h * 64 + c), w1v = *(const f32x4*)(a.in[I_WUP] + (size_t)r * 1024 + h * 64 + c + 4);
        const f32x4 a0v = *(const f32x4*)(a.in[I_AUP] + (size_t)r * 1024 + h * 64 + c), a1v = *(const f32x4*)(a.in[I_AUP] + (size_t)r * 1024 + h * 64 + c + 4);
        u32x4 pw; pw.x = pk2(w0v[0], w0v[1]); pw.y = pk2(w0v[2], w0v[3]); pw.z = pk2(w1v[0], w1v[1]); pw.w = pk2(w1v[2], w1v[3]);
        u32x4 pa; pa.x = pk2(a0v[0], a0v[1]); pa.y = pk2(a0v[2], a0v[3]); pa.z = pk2(a1v[0], a1v[1]); pa.w = pk2(a1v[2], a1v[3]);
        *(LAS u32x4*)(lds + RC_WUP + r * MP + c * 2) = pw; *(LAS u32x4*)(lds + RC_AUP + r * MP + c * 2) = pa; }
    const int pt = tid >> 3, c8 = (tid & 7) * 8, ch = h * 64 + c8;
    if (tid < 64) { LAS float* cst = (LAS float*)(lds + RC_CST); const int hc = h * 64 + tid;
        cst[0 * 64 + tid] = a.in[I_MU][hc]; cst[1 * 64 + tid] = a.in[I_MU][1024 + hc]; cst[2 * 64 + tid] = a.in[I_MU][2048 + hc]; cst[3 * 64 + tid] = a.in[I_MU][3072 + tid]; cst[4 * 64 + tid] = a.in[I_MU][3136 + tid];
        cst[5 * 64 + tid] = a.in[I_W0][hc]; cst[6 * 64 + tid] = a.in[I_A0][hc]; cst[7 * 64 + tid] = a.in[I_KK][hc]; cst[8 * 64 + tid] = a.in[I_KA][hc]; cst[9 * 64 + tid] = a.in[I_RK][hc];
        cst[10 * 64 + tid] = a.in[I_LNG][hc]; cst[11 * 64 + tid] = a.in[I_LNB][hc]; }
#define CSTV(name, idx) float name[8]; { const f32x4 _c0 = *(LAS f32x4*)(lds + RC_CST + (idx) * 256 + c8 * 4), _c1 = *(LAS f32x4*)(lds + RC_CST + (idx) * 256 + c8 * 4 + 16); \
        name[0] = _c0[0]; name[1] = _c0[1]; name[2] = _c0[2]; name[3] = _c0[3]; name[4] = _c1[0]; name[5] = _c1[1]; name[6] = _c1[2]; name[7] = _c1[3]; }
    const int wq = w & 3, rb = wq >> 1, cb = wq & 1;
    f32x16 macc = zero16();
    __syncthreads();
    for (int ck = 0; ck < T / 64; ++ck) {
        const int tpos = ck * 64 + pt; const size_t tok = (size_t)b * T + tpos;
        float rs[8], kk[8], kp[8], vs[8], lwv[8], av[8], bc;
        {
            const bf16* zr = zrkv + tok * 3072 + ch;
            const u32x4 rc = *(const u32x4*)(zr), kc = *(const u32x4*)(zr + 1024), vc = *(const u32x4*)(zr + 2048);
            u32x4 rp = (u32x4){0u, 0u, 0u, 0u}, kq = rp, vp = rp; f32x4 wdp0 = (f32x4){0.f, 0.f, 0.f, 0.f}, wdp1 = wdp0, adp0 = wdp0, adp1 = wdp0;
            const float* zs = zsm + tok * 1024;
            const f32x4 wdc0 = *(const f32x4*)(zs + ZS_WD + c8), wdc1 = *(const f32x4*)(zs + ZS_WD + c8 + 4), adc0 = *(const f32x4*)(zs + ZS_AD + c8), adc1 = *(const f32x4*)(zs + ZS_AD + c8 + 4);
            if (tpos > 0) { rp = *(const u32x4*)(zr - 3072); kq = *(const u32x4*)(zr - 3072 + 1024); vp = *(const u32x4*)(zr - 3072 + 2048);
                wdp0 = *(const f32x4*)(zs - 1024 + ZS_WD + c8); wdp1 = *(const f32x4*)(zs - 1024 + ZS_WD + c8 + 4); adp0 = *(const f32x4*)(zs - 1024 + ZS_AD + c8); adp1 = *(const f32x4*)(zs - 1024 + ZS_AD + c8 + 4); }
            float wds[8], ads[8];
            CSTV(mu_r, 0) CSTV(mu_k, 1) CSTV(mu_v, 2) CSTV(mu_wd, 3) CSTV(mu_ad, 4)
#pragma unroll
            for (int j = 0; j < 4; ++j) {
                const unsigned rw = j == 0 ? rc.x : j == 1 ? rc.y : j == 2 ? rc.z : rc.w, rpw = j == 0 ? rp.x : j == 1 ? rp.y : j == 2 ? rp.z : rp.w;
                const unsigned kw = j == 0 ? kc.x : j == 1 ? kc.y : j == 2 ? kc.z : kc.w, kpw = j == 0 ? kq.x : j == 1 ? kq.y : j == 2 ? kq.z : kq.w;
                const unsigned vw = j == 0 ? vc.x : j == 1 ? vc.y : j == 2 ? vc.z : vc.w, vpw = j == 0 ? vp.x : j == 1 ? vp.y : j == 2 ? vp.z : vp.w;
                rs[2 * j] = bflo(rw) + mu_r[2 * j] * (bflo(rpw) - bflo(rw)); rs[2 * j + 1] = bfhi(rw) + mu_r[2 * j + 1] * (bfhi(rpw) - bfhi(rw));
                kk[2 * j] = bflo(kw) + mu_k[2 * j] * (bflo(kpw) - bflo(kw)); kk[2 * j + 1] = bfhi(kw) + mu_k[2 * j + 1] * (bfhi(kpw) - bfhi(kw));
                vs[2 * j] = bflo(vw) + mu_v[2 * j] * (bflo(vpw) - bflo(vw)); vs[2 * j + 1] = bfhi(vw) + mu_v[2 * j + 1] * (bfhi(vpw) - bfhi(vw));
                wds[j] = wdc0[j] + mu_wd[j] * (wdp0[j] - wdc0[j]); wds[4 + j] = wdc1[j] + mu_wd[4 + j] * (wdp1[j] - wdc1[j]);
                ads[j] = adc0[j] + mu_ad[j] * (adp0[j] - adc0[j]); ads[4 + j] = adc1[j] + mu_ad[4 + j] * (adp1[j] - adc1[j]); }
            u32x4 pw, pa; pw.x = pk2(tanh_fast(wds[0]), tanh_fast(wds[1])); pw.y = pk2(tanh_fast(wds[2]), tanh_fast(wds[3])); pw.z = pk2(tanh_fast(wds[4]), tanh_fast(wds[5])); pw.w = pk2(tanh_fast(wds[6]), tanh_fast(wds[7]));
            pa.x = pk2(ads[0], ads[1]); pa.y = pk2(ads[2], ads[3]); pa.z = pk2(ads[4], ads[5]); pa.w = pk2(ads[6], ads[7]);
            *(LAS u32x4*)(lds + RC_WDT + pt * MP + c8 * 2) = pw; *(LAS u32x4*)(lds + RC_ADT + pt * MP + c8 * 2) = pa;
        }
        __syncthreads();
        {
            f32x16 acc = zero16();
            if (w < 4) { mm_acc<false, true>(acc, lds + RC_WDT, lds + RC_WUP, rb, cb, lane); st_tile_f32(lds + RC_WPRE, acc, rb, cb, lane); }
            else       { mm_acc<false, true>(acc, lds + RC_ADT, lds + RC_AUP, rb, cb, lane); st_tile_f32(lds + RC_APRE, acc, rb, cb, lane); }
        }
        __syncthreads();
        {
            const f32x4 wp0 = *(LAS f32x4*)(lds + RC_WPRE + pt * FP + c8 * 4), wp1 = *(LAS f32x4*)(lds + RC_WPRE + pt * FP + c8 * 4 + 16);
            const f32x4 ap0 = *(LAS f32x4*)(lds + RC_APRE + pt * FP + c8 * 4), ap1 = *(LAS f32x4*)(lds + RC_APRE + pt * FP + c8 * 4 + 16);
            float n2 = 0.f; bc = 0.f; float ksv[8];
            CSTV(w0, 5) CSTV(a0, 6) CSTV(k_k, 7) CSTV(k_a, 8) CSTV(r_k, 9)
#pragma unroll
            for (int j = 0; j < 8; ++j) { const float wp = w0[j] + (j < 4 ? wp0[j & 3] : wp1[j & 3]), ap = a0[j] + (j < 4 ? ap0[j & 3] : ap1[j & 3]);
                lwv[j] = -__expf(-softplus_f(-wp) - 0.5f); av[j] = __builtin_amdgcn_rcpf(1.0f + __expf(-ap));
                ksv[j] = kk[j]; kk[j] = ksv[j] * k_k[j]; n2 += kk[j] * kk[j]; }
            n2 = allsum8(n2); const float inv = 1.0f / fmaxf(sqrtf(n2), 1e-12f);
#pragma unroll
            for (int j = 0; j < 8; ++j) { kk[j] *= inv; kp[j] = ksv[j] * (1.0f + (av[j] - 1.0f) * k_a[j]); bc += rs[j] * kp[j] * r_k[j]; }
            bc = allsum8(bc);
            *(LAS f32x4*)(lds + RC_LW + pt * FP + c8 * 4) = (f32x4){lwv[0], lwv[1], lwv[2], lwv[3]}; *(LAS f32x4*)(lds + RC_LW + pt * FP + c8 * 4 + 16) = (f32x4){lwv[4], lwv[5], lwv[6], lwv[7]};
        }
        __syncthreads();
        {
            const int kc = tid & 63, g = tid >> 6; float run = 0.f;
#pragma unroll
            for (int j = 0; j < 8; ++j) { LAS float* pp = (LAS float*)(lds + RC_LW + (8 * g + j) * FP + kc * 4); run += *pp; *pp = run; }
            *(LAS float*)(lds + RC_TOT + g * 256 + kc * 4) = run;
        }
        __syncthreads();
        {   const int kc = tid & 63, g = tid >> 6; float off = 0.f;
            for (int gg = 0; gg < g; ++gg) off += *(LAS float*)(lds + RC_TOT + gg * 256 + kc * 4);
#pragma unroll
            for (int j = 0; j < 8; ++j) { LAS float* pp = (LAS float*)(lds + RC_LW + (8 * g + j) * FP + kc * 4); *pp += off; }
        }
        __syncthreads();
        {
            const f32x4 c0 = *(LAS f32x4*)(lds + RC_LW + pt * FP + c8 * 4), c1 = *(LAS f32x4*)(lds + RC_LW + pt * FP + c8 * 4 + 16);
            const f32x4 m0 = *(LAS f32x4*)(lds + RC_LW + 31 * FP + c8 * 4), m1 = *(LAS f32x4*)(lds + RC_LW + 31 * FP + c8 * 4 + 16);
            float at[8], rt[8], bt[8], kt[8];
#pragma unroll
            for (int j = 0; j < 8; ++j) { const float cin = j < 4 ? c0[j & 3] : c1[j & 3], mm = j < 4 ? m0[j & 3] : m1[j & 3];
                const float er = __expf(cin - mm), ea = er * __expf(-lwv[j]), eb = __builtin_amdgcn_rcpf(er);
                at[j] = -kk[j] * ea; rt[j] = rs[j] * er; bt[j] = kk[j] * av[j] * eb; kt[j] = kp[j] * eb; }
            u32x4 pw;
            pw.x = pk2(at[0], at[1]); pw.y = pk2(at[2], at[3]); pw.z = pk2(at[4], at[5]); pw.w = pk2(at[6], at[7]); *(LAS u32x4*)(lds + RC_AT + pt * MP + c8 * 2) = pw;
            pw.x = pk2(rt[0], rt[1]); pw.y = pk2(rt[2], rt[3]); pw.z = pk2(rt[4], rt[5]); pw.w = pk2(rt[6], rt[7]); *(LAS u32x4*)(lds + RC_RT + pt * MP + c8 * 2) = pw;
            pw.x = pk2(bt[0], bt[1]); pw.y = pk2(bt[2], bt[3]); pw.z = pk2(bt[4], bt[5]); pw.w = pk2(bt[6], bt[7]); *(LAS u32x4*)(lds + RC_BT + pt * MP + c8 * 2) = pw;
            pw.x = pk2(kt[0], kt[1]); pw.y = pk2(kt[2], kt[3]); pw.z = pk2(kt[4], kt[5]); pw.w = pk2(kt[6], kt[7]); *(LAS u32x4*)(lds + RC_KT + pt * MP + c8 * 2) = pw;
            pw.x = pk2(vs[0], vs[1]); pw.y = pk2(vs[2], vs[3]); pw.z = pk2(vs[4], vs[5]); pw.w = pk2(vs[6], vs[7]); *(LAS u32x4*)(lds + RC_VT + pt * MP + c8 * 2) = pw;
            if (pt == 0) { const f32x4 l0 = *(LAS f32x4*)(lds + RC_LW + 63 * FP + c8 * 4), l1 = *(LAS f32x4*)(lds + RC_LW + 63 * FP + c8 * 4 + 16);
#pragma unroll
                for (int j = 0; j < 8; ++j) { const float mm = j < 4 ? m0[j & 3] : m1[j & 3], cl = j < 4 ? l0[j & 3] : l1[j & 3];
                    *(LAS float*)(lds + RC_VEC + (c8 + j) * 4) = __expf(mm); *(LAS float*)(lds + RC_VEC + 256 + (c8 + j) * 4) = __expf(cl); *(LAS float*)(lds + RC_VEC + 512 + (c8 + j) * 4) = __expf(cl - mm); } }
        }
        __syncthreads();
        if (w < 4) { f32x16 acc = zero16(); mm_acc<false, false>(acc, lds + RC_AT, lds + RC_BT, rb, cb, lane); mask_tril<false>(acc, rb, cb, lane);
            st_tile_bf16(lds + RC_XA, acc, rb, cb, lane);
            const int row = 32 * rb + (lane & 31);
#pragma unroll
            for (int j = 0; j < 16; ++j) { const int col = 32 * cb + (j & 3) + 8 * (j >> 2) + 4 * (lane >> 5); macc[j] = acc[j] + (col == row ? 1.0f : 0.0f); }
            st_tile_bf16(lds + RC_TA, macc, rb, cb, lane);
        } else { const float em = *(LAS float*)(lds + RC_VEC + (32 * rb + (lane & 31)) * 4); f32x16 sc;
#pragma unroll
            for (int j = 0; j < 16; ++j) sc[j] = macc[j] * em;
            st_tile_bf16(lds + RC_S0, sc, rb, cb, lane);
            f32x16 acc = zero16(); mm_acc<false, false>(acc, lds + RC_AT, lds + RC_KT, rb, cb, lane); mask_tril<false>(acc, rb, cb, lane); st_tile_bf16(lds + RC_MAK, acc, rb, cb, lane); }
        __syncthreads();
        if (w < 4) { f32x16 acc = zero16(); mm_acc<false, true>(acc, lds + RC_XA, lds + RC_XA, rb, cb, lane); st_tile_bf16(lds + RC_XB, acc, rb, cb, lane); }
        else { f32x16 acc = zero16(); mm_acc<false, false>(acc, lds + RC_RT, lds + RC_BT, rb, cb, lane); mask_tril<true>(acc, rb, cb, lane); st_tile_bf16(lds + RC_NRB, acc, rb, cb, lane); }
        __syncthreads();
        if (w < 4) { mm_acc<false, true>(macc, lds + RC_TA, lds + RC_XB, rb, cb, lane); st_tile_bf16(lds + RC_TB, macc, rb, cb, lane); }
        else { f32x16 acc = zero16(); mm_acc<false, true>(acc, lds + RC_XB, lds + RC_XB, rb, cb, lane); st_tile_bf16(lds + RC_XA, acc, rb, cb, lane); }
        __syncthreads();
        if (w < 4) { mm_acc<false, true>(macc, lds + RC_TB, lds + RC_XA, rb, cb, lane); st_tile_bf16(lds + RC_TA, macc, rb, cb, lane); }
        else { f32x16 acc = zero16(); mm_acc<false, true>(acc, lds + RC_XA, lds + RC_XA, rb, cb, lane); st_tile_bf16(lds + RC_XB, acc, rb, cb, lane); }
        __syncthreads();
        if (w < 4) { mm_acc<false, true>(macc, lds + RC_TA, lds + RC_XB, rb, cb, lane); st_tile_bf16(lds + RC_TB, macc, rb, cb, lane); }
        else { f32x16 acc = zero16(); mm_acc<false, true>(acc, lds + RC_XB, lds + RC_XB, rb, cb, lane); st_tile_bf16(lds + RC_XA, acc, rb, cb, lane); }
        __syncthreads();
        if (w < 4) { mm_acc<false, true>(macc, lds + RC_TB, lds + RC_XA, rb, cb, lane); st_tile_bf16(lds + RC_TA, macc, rb, cb, lane); }
        else { f32x16 acc = zero16(); mm_acc<false, true>(acc, lds + RC_XA, lds + RC_XA, rb, cb, lane); st_tile_bf16(lds + RC_XB, acc, rb, cb, lane); }
        __syncthreads();
        if (w < 4) { mm_acc<false, true>(macc, lds + RC_TA, lds + RC_XB, rb, cb, lane); st_tile_bf16(lds + RC_TB, macc, rb, cb, lane); }
        else { f32x16 acc = zero16(); mm_acc<false, false>(acc, lds + RC_RT, lds + RC_KT, rb, cb, lane); mask_tril<true>(acc, rb, cb, lane); st_tile_bf16(lds + RC_NRK, acc, rb, cb, lane);
            acc = zero16(); mm_acc<false, true>(acc, lds + RC_AT, lds + RC_S0, rb, cb, lane); mm_acc<false, true>(acc, lds + RC_MAK, lds + RC_VT, rb, cb, lane); st_tile_bf16(lds + RC_XA, acc, rb, cb, lane); }
        __syncthreads();
        if (w < 4) { f32x16 acc = zero16(); mm_acc<false, true>(acc, lds + RC_TB, lds + RC_XA, rb, cb, lane); st_tile_bf16(lds + RC_TA, acc, rb, cb, lane); }
        __syncthreads();
        if (w < 4) { f32x16 acc = zero16(); mm_acc<false, true>(acc, lds + RC_RT, lds + RC_S0, rb, cb, lane); mm_acc<false, true>(acc, lds + RC_NRB, lds + RC_TA, rb, cb, lane); mm_acc<false, true>(acc, lds + RC_NRK, lds + RC_VT, rb, cb, lane);
            st_tile_f32(lds + RC_YF, acc, rb, cb, lane); }
        else { f32x16 acc = zero16(); mm_acc<true, true>(acc, lds + RC_BT, lds + RC_TA, rb, cb, lane); mm_acc<true, true>(acc, lds + RC_KT, lds + RC_VT, rb, cb, lane);
            const float ecl = *(LAS float*)(lds + RC_VEC + 256 + (32 * rb + (lane & 31)) * 4), eclm = *(LAS float*)(lds + RC_VEC + 512 + (32 * rb + (lane & 31)) * 4);
#pragma unroll
            for (int j = 0; j < 16; ++j) macc[j] = ecl * macc[j] + eclm * acc[j]; }
        __syncthreads();
        {
            const f32x4 y0 = *(LAS f32x4*)(lds + RC_YF + pt * FP + c8 * 4), y1 = *(LAS f32x4*)(lds + RC_YF + pt * FP + c8 * 4 + 16);
            float yv[8];
#pragma unroll
            for (int j = 0; j < 8; ++j) yv[j] = j < 4 ? y0[j & 3] : y1[j & 3];
            float sm = 0.f;
#pragma unroll
            for (int j = 0; j < 8; ++j) sm += yv[j];
            const float mean = allsum8(sm) * (1.0f / 64.0f); float sq = 0.f;
#pragma unroll
            for (int j = 0; j < 8; ++j) { yv[j] -= mean; sq += yv[j] * yv[j]; }
            const float rstd = rsqrtf(allsum8(sq) * (1.0f / 64.0f) + 64e-5f);
            const u32x4 g4 = *(const u32x4*)(gates + tok * 2048 + ch);
            float o[8];
            CSTV(ln_g, 10) CSTV(ln_b, 11)
#pragma unroll
            for (int j = 0; j < 4; ++j) { const unsigned gw = j == 0 ? g4.x : j == 1 ? g4.y : j == 2 ? g4.z : g4.w;
                o[2 * j] = (yv[2 * j] * rstd * ln_g[2 * j] + ln_b[2 * j] + bc * vs[2 * j]) * bflo(gw);
                o[2 * j + 1] = (yv[2 * j + 1] * rstd * ln_g[2 * j + 1] + ln_b[2 * j + 1] + bc * vs[2 * j + 1]) * bfhi(gw); }
            u32x4 ow; ow.x = pk2(o[0], o[1]); ow.y = pk2(o[2], o[3]); ow.z = pk2(o[4], o[5]); ow.w = pk2(o[6], o[7]);
            *(u32x4*)(mixed + tok * 2048 + ch) = ow;
        }
        __syncthreads();
    }
}

constexpr int CS_PITCH = 528;
constexpr int DSA_SEL = 135168, DSA_PB = 139264, DSA_BIAS = 147712, DSA_XCH = 149760;
__device__ __forceinline__ unsigned fkey(float x) { const unsigned u = __builtin_bit_cast(unsigned, x); return (u & 0x80000000u) ? ~u : (u | 0x80000000u); }
__device__ __forceinline__ int mbcnt64(unsigned long long m) { return __builtin_amdgcn_mbcnt_hi((unsigned)(m >> 32), __builtin_amdgcn_mbcnt_lo((unsigned)m, 0u)); }
__device__ __forceinline__ int t5_bucket(int rel) {
    const int n = rel < 0 ? -rel : rel; int r = rel > 0 ? 16 : 0;
    if (n < 8) return r + n;
    int large = 2 + (31 - __clz(n * n)); if (large > 15) large = 15;
    return r + large;
}
__device__ __forceinline__ void dsa_unit(const Args& a, LAS unsigned char* lds, int b, int qg) {
    const int tid = threadIdx.x, lane = tid & 63, w = __builtin_amdgcn_readfirstlane(tid >> 6);
    unsigned char* ws = a.ws;
    const bf16* qidx = (const bf16*)(ws + WS_QIDX); const bf16* kidx = (const bf16*)(ws + WS_KIDX); const float* widx = (const float*)(ws + WS_WIDX);
    const bf16* ckv = (const bf16*)(ws + WS_CKV); bf16* qabs = (bf16*)a.out;
    LAS float* SC = (LAS float*)lds; LAS unsigned char* CS = lds;
    LAS unsigned short* SEL = (LAS unsigned short*)(lds + DSA_SEL); LAS unsigned char* PB = lds + DSA_PB;
    LAS float* BIAS = (LAS float*)(lds + DSA_BIAS); LAS float* XCH = (LAS float*)(lds + DSA_XCH);
    const int q0 = qg * 8, L = ((q0 >> 6) + 1) * 64, nk = L < 256 ? L : 256;
    const size_t tok0 = (size_t)b * T + q0, kb = (size_t)b * T;
    BIAS[tid] = a.in[I_RELB][tid];
    for (int rep_a = 0; rep_a < ((PROBE_DUP & 16) ? 2 : 1); ++rep_a)
    if (L > 256) {
        const int rb = w & 3, kh = w >> 2, i = lane & 31, half = lane >> 5;
        const int ql = 2 * rb + ((i >> 2) & 1), head = (i & 3) | ((i >> 3) << 2);
        bf16x8 af[4];
#pragma unroll
        for (int ks = 0; ks < 4; ++ks) af[ks] = *(const bf16x8*)(qidx + (tok0 + ql) * 1024 + head * 64 + ks * 16 + half * 8);
        const int qo = 2 * rb + half; float wq[16];
#pragma unroll
        for (int j = 0; j < 4; ++j) { const f32x4 v = *(const f32x4*)(widx + (tok0 + qo) * 16 + j * 4); wq[j * 4 + 0] = v[0]; wq[j * 4 + 1] = v[1]; wq[j * 4 + 2] = v[2]; wq[j * 4 + 3] = v[3]; }
        const int ntile = L / 64;
        const bf16* kp0 = kidx + (kb + i) * 64 + half * 8;
        bf16x8 bA[4], bB[4], bC[4];
#pragma unroll
        for (int ks = 0; ks < 4; ++ks) { bA[ks] = *(const bf16x8*)(kp0 + (size_t)(kh) * 32 * 64 + ks * 16); bB[ks] = *(const bf16x8*)(kp0 + (size_t)(kh + 2) * 32 * 64 + ks * 16); }
        for (int n = 0; n < ntile; ++n) {
            const int kt = kh + 2 * n; const int ktn = (n + 2 < ntile) ? kt + 4 : kt;
#pragma unroll
            for (int ks = 0; ks < 4; ++ks) bC[ks] = *(const bf16x8*)(kp0 + (size_t)ktn * 32 * 64 + ks * 16);
            f32x16 acc;
#pragma unroll
            for (int j = 0; j < 16; ++j) acc[j] = 0.f;
#pragma unroll
            for (int ks = 0; ks < 4; ++ks) acc = __builtin_amdgcn_mfma_f32_32x32x16_bf16(af[ks], bA[ks], acc, 0, 0, 0);
            float sc = 0.f;
#pragma unroll
            for (int j = 0; j < 16; ++j) sc += wq[j] * fmaxf(acc[j], 0.f);
            SC[qo * 4096 + kt * 32 + i] = sc;
#pragma unroll
            for (int ks = 0; ks < 4; ++ks) { bA[ks] = bB[ks]; bB[ks] = bC[ks]; }
        }
    }
    __syncthreads();
    for (int rep_b = 0; rep_b < ((PROBE_DUP & 32) ? 2 : 1); ++rep_b)
    if (L <= 256) {
        for (int j = lane; j < 256; j += 64) SEL[w * 256 + j] = (unsigned short)j;
    } else {
        const int nreg = L / 64; unsigned u[64];
#pragma unroll
        for (int j = 0; j < 64; ++j) u[j] = (j < nreg) ? fkey(SC[w * 4096 + j * 64 + lane]) : 0u;
        unsigned thr = 0u;
        for (int bit = 31; bit >= 0; --bit) { const unsigned cand = thr | (1u << bit); int c0 = 0, c1 = 0;
#pragma unroll
            for (int j = 0; j < 64; j += 2) { c0 += (u[j] >= cand) ? 1 : 0; c1 += (u[j + 1] >= cand) ? 1 : 0; }
            int cl = c0 + c1;
            cl += __builtin_amdgcn_update_dpp(0, cl, 0xB1, 0xF, 0xF, true); cl += __builtin_amdgcn_update_dpp(0, cl, 0x4E, 0xF, 0xF, true);
            cl += __builtin_amdgcn_update_dpp(0, cl, 0x141, 0xF, 0xF, true); cl += __builtin_amdgcn_update_dpp(0, cl, 0x140, 0xF, 0xF, true);
            const int cnt = __builtin_amdgcn_readlane(cl, 0) + __builtin_amdgcn_readlane(cl, 16) + __builtin_amdgcn_readlane(cl, 32) + __builtin_amdgcn_readlane(cl, 48);
            if (cnt >= 256) thr = cand; }
        int ngt = 0;
#pragma unroll
        for (int j = 0; j < 64; ++j) if (j < nreg) ngt += __popcll(__ballot(u[j] > thr));
        int ties_left = 256 - ngt, pos = 0;
#pragma unroll
        for (int j = 0; j < 64; ++j) if (j < nreg) {
            const bool gt = u[j] > thr, eq = u[j] == thr;
            const unsigned long long em = __ballot(eq);
            const bool take = gt || (eq && mbcnt64(em) < ties_left);
            const unsigned long long tm = __ballot(take);
            if (take) SEL[w * 256 + pos + mbcnt64(tm)] = (unsigned short)(j * 64 + lane);
            pos += __popcll(tm); const int ne = __popcll(em); ties_left -= (ne < ties_left ? ne : ties_left);
        }
    }
    __syncthreads();
    const int fr = lane & 15, hq = lane >> 4;
    for (int jq2 = 0; jq2 < ((PROBE_DUP & 64) ? 16 : 8); ++jq2) {
        const int jq = (PROBE_DUP & 64) ? (jq2 >> 1) : jq2; const bool do_store = (PROBE_DUP & 64) ? (jq2 & 1) : true;
        const int qpos = q0 + jq; const size_t tok = tok0 + jq;
        const bool active = (32 * w < nk);
        if (active) {
            u32x4 gv[16];
#pragma unroll
            for (int it = 0; it < 16; ++it) { const int kl = 32 * w + 2 * it + (lane >> 5); const int idx = SEL[jq * 256 + kl];
                gv[it] = *(const u32x4*)(ckv + (kb + idx) * KVR + (lane & 31) * 8); }
#pragma unroll
            for (int it = 0; it < 16; ++it) { const int kl = 32 * w + 2 * it + (lane >> 5); *(LAS u32x4*)(CS + kl * CS_PITCH + (lane & 31) * 16) = gv[it]; }
        }
        bf16x8 aq[8];
#pragma unroll
        for (int ks = 0; ks < 8; ++ks) aq[ks] = *(const bf16x8*)(qabs + tok * 4096 + fr * 256 + ks * 32 + hq * 8);
        __syncthreads();
        f32x4 sv[2]; float gmax[4];
        if (active) {
#pragma unroll
            for (int j = 0; j < 2; ++j) { f32x4 acc = (f32x4){0.f, 0.f, 0.f, 0.f};
#pragma unroll
                for (int ks = 0; ks < 8; ++ks) { const bf16x8 bfr = *(LAS bf16x8*)(CS + (32 * w + 16 * j + fr) * CS_PITCH + (ks * 32 + hq * 8) * 2); acc = __builtin_amdgcn_mfma_f32_16x16x32_bf16(aq[ks], bfr, acc, 0, 0, 0); }
                const int kidxv = SEL[jq * 256 + 32 * w + 16 * j + fr]; const int bk = t5_bucket(kidxv - qpos);
                const f32x4 bv = *(LAS f32x4*)(BIAS + bk * 16 + hq * 4);
                sv[j] = acc + bv; }
#pragma unroll
            for (int r = 0; r < 4; ++r) { const float m = allmax16(fmaxf(sv[0][r], sv[1][r])); if (fr == 0) XCH[w * 16 + hq * 4 + r] = m; }
        } else if (fr == 0) {
#pragma unroll
            for (int r = 0; r < 4; ++r) XCH[w * 16 + hq * 4 + r] = -3.0e38f;
        }
        __syncthreads();
#pragma unroll
        for (int r = 0; r < 4; ++r) gmax[r] = -3.0e38f;
#pragma unroll
        for (int ww = 0; ww < 8; ++ww) { const f32x4 m = *(LAS f32x4*)(XCH + ww * 16 + hq * 4);
#pragma unroll
            for (int r = 0; r < 4; ++r) gmax[r] = fmaxf(gmax[r], m[r]); }
        if (active) {
#pragma unroll
            for (int r = 0; r < 4; ++r) { const float p0 = __expf(sv[0][r] - gmax[r]), p1 = __expf(sv[1][r] - gmax[r]);
                const float ps = allsum16(p0 + p1); if (fr == 0) XCH[128 + w * 16 + hq * 4 + r] = ps;
                *(LAS unsigned short*)(PB + (hq * 4 + r) * CS_PITCH + (32 * w + fr) * 2) = (unsigned short)f2bf(p0);
                *(LAS unsigned short*)(PB + (hq * 4 + r) * CS_PITCH + (32 * w + 16 + fr) * 2) = (unsigned short)f2bf(p1); }
        } else if (fr == 0) {
#pragma unroll
            for (int r = 0; r < 4; ++r) XCH[128 + w * 16 + hq * 4 + r] = 0.f;
        }
        __syncthreads();
        {
            f32x4 o0 = (f32x4){0.f, 0.f, 0.f, 0.f}, o1 = o0;
            const int g = lane >> 4, qq = (lane & 15) >> 2, pp = lane & 3;
            for (int ks = 0; ks < nk / 32; ++ks) {
                const bf16x8 pa = *(LAS bf16x8*)(PB + fr * CS_PITCH + (ks * 32 + hq * 8) * 2);
                LAS unsigned char* base = CS + (ks * 32 + 8 * g + qq) * CS_PITCH + (32 * w + 4 * pp) * 2;
                const s16x4 b00 = __builtin_amdgcn_ds_read_tr16_b64_v4i16((LAS s16x4*)(base));
                const s16x4 b01 = __builtin_amdgcn_ds_read_tr16_b64_v4i16((LAS s16x4*)(base + 4 * CS_PITCH));
                const s16x4 b10 = __builtin_amdgcn_ds_read_tr16_b64_v4i16((LAS s16x4*)(base + 32));
                const s16x4 b11 = __builtin_amdgcn_ds_read_tr16_b64_v4i16((LAS s16x4*)(base + 32 + 4 * CS_PITCH));
                const bf16x8 bf0 = (bf16x8){b00[0], b00[1], b00[2], b00[3], b01[0], b01[1], b01[2], b01[3]};
                const bf16x8 bf1 = (bf16x8){b10[0], b10[1], b10[2], b10[3], b11[0], b11[1], b11[2], b11[3]};
                o0 = __builtin_amdgcn_mfma_f32_16x16x32_bf16(pa, bf0, o0, 0, 0, 0);
                o1 = __builtin_amdgcn_mfma_f32_16x16x32_bf16(pa, bf1, o1, 0, 0, 0);
            }
            float ls[4];
#pragma unroll
            for (int r = 0; r < 4; ++r) ls[r] = 0.f;
#pragma unroll
            for (int ww = 0; ww < 8; ++ww) { const f32x4 m = *(LAS f32x4*)(XCH + 128 + ww * 16 + hq * 4);
#pragma unroll
                for (int r = 0; r < 4; ++r) ls[r] += m[r]; }
#pragma unroll
            for (int r = 0; r < 4; ++r) { const float inv = 1.0f / ls[r]; bf16* op = qabs + tok * 4096 + (hq * 4 + r) * 256 + 32 * w + fr;
                if (do_store) { op[0] = (bf16)f2bf(o0[r] * inv); op[16] = (bf16)f2bf(o1[r] * inv); } else { asm volatile("" :: "v"(o0[r] * inv), "v"(o1[r] * inv)); } }
        }
        __syncthreads();
    }
}

__device__ __forceinline__ void uv_unit(const Args& a, int tt, int h) {
    const int tid = threadIdx.x, lane = tid & 63, w = tid >> 6, mt = w & 3, nt = w >> 2, i = lane & 31, half = lane >> 5;
    unsigned char* ws = a.ws; const bf16* ol = (const bf16*)a.out; const bf16* wuvt = (const bf16*)(ws + WS_WUVT); const bf16* gates = (const bf16*)(ws + WS_GATES); bf16* mixed = (bf16*)(ws + WS_XN);
    const size_t row = (size_t)tt * 128 + mt * 32 + i;
    const bf16* ap = ol + row * 4096 + h * 256 + half * 8; const bf16* bp = wuvt + (size_t)(h * 64 + nt * 32 + i) * KVR + half * 8;
    f32x16 acc;
#pragma unroll
    for (int j = 0; j < 16; ++j) acc[j] = 0.f;
#pragma unroll 4
    for (int ks = 0; ks < 16; ++ks) { const bf16x8 av = *(const bf16x8*)(ap + ks * 16), bv = *(const bf16x8*)(bp + ks * 16); acc = __builtin_amdgcn_mfma_f32_32x32x16_bf16(av, bv, acc, 0, 0, 0); }
    const int col = h * 64 + nt * 32 + i;
#pragma unroll
    for (int r = 0; r < 16; ++r) { const size_t orow = (size_t)tt * 128 + mt * 32 + (r & 3) + 8 * (r >> 2) + 4 * half;
        const float gv = bf1(gates[orow * 2048 + 1024 + col]); mixed[orow * 2048 + 1024 + col] = (bf16)f2bf(acc[r] * gv); }
}

__device__ __forceinline__ void phase8(const Args& a) {
    const int tid = threadIdx.x, lane = tid & 63, wave = tid >> 6, G = gridDim.x, bx = blockIdx.x;
    const float* part = (const float*)(a.ws + WS_PART); const float* g = a.in[I_FINALG]; float* out = a.out;
    for (int row = bx * NWAVES + wave; row < M; row += G * NWAVES) {
        float ss = (lane < 32) ? part[(size_t)row * 32 + lane] : 0.f; ss = wave_sum(ss);
        const float r = rsqrtf(ss * (1.0f / D) + 1e-6f); float* orow = out + (size_t)row * D;
#pragma unroll
        for (int i = 0; i < 8; ++i) { const int c = (i * 64 + lane) * 4; f32x4 v = *(const f32x4*)(orow + c); const f32x4 gg = *(const f32x4*)(g + c);
            v[0] = v[0] * r * gg[0]; v[1] = v[1] * r * gg[1]; v[2] = v[2] * r * gg[2]; v[3] = v[3] * r * gg[3]; *(f32x4*)(orow + c) = v; }
    }
}

#define XB_TMO      128
#define XB_XCNT(j)  (256  + 64 * (j))
#define XB_XSUB(j)  (1280 + 64 * (j))
#define XB_XGEN(j)  (2304 + 64 * (j))
#define XB_TOP      3328
#define XB_TOPGEN   3392
#define XCD_BAR_WORDS 3456
#define XB_SPIN_CAP (1u << 18)

__device__ __forceinline__ unsigned xb_ld(unsigned* p)              { return __hip_atomic_load(p, __ATOMIC_RELAXED, __HIP_MEMORY_SCOPE_AGENT); }
__device__ __forceinline__ unsigned xb_add(unsigned* p, unsigned v) { return __hip_atomic_fetch_add(p, v, __ATOMIC_RELAXED, __HIP_MEMORY_SCOPE_AGENT); }
__device__ __forceinline__ unsigned xb_xcc_id() { return (unsigned)__builtin_amdgcn_s_getreg((3 << 11) | 20) & 0xFu; }
#define XB_SPIN(cond, bar) do { unsigned _sp = 0; while (cond) { __builtin_amdgcn_s_sleep(1); \
    if ((++_sp & 255u) == 0u) { if (xb_ld(&(bar)[XB_TMO])) break; if (_sp > XB_SPIN_CAP) { atomicAdd(&(bar)[XB_TMO], 1u); break; } } } } while (0)

struct XcdBarrier {
    unsigned* bar; unsigned x;
    volatile LAS unsigned* st;
};

__device__ __forceinline__ XcdBarrier xcd_barrier_post(unsigned* bar, volatile LAS unsigned* st) {
    XcdBarrier b; b.bar = bar; b.x = xb_xcc_id(); b.st = st;
    if (threadIdx.x == 0) (void)xb_add(&bar[XB_XCNT(b.x)], 1u);
    return b;
}
__device__ __forceinline__ void xcd_barrier_complete(unsigned* bar, unsigned x, unsigned& nloc, unsigned& nx) {
    const unsigned G = gridDim.x * gridDim.y * gridDim.z;
    unsigned sum, cnt, mine, sp = 0u;
    for (;;) {
        sum = 0u; cnt = 0u; mine = 0u;
#pragma unroll
        for (unsigned j = 0; j < 16; ++j) { const unsigned c = xb_ld(&bar[XB_XCNT(j)]); sum += c; cnt += (c > 0u) ? 1u : 0u; mine = (j == x) ? c : mine; }
        if (sum == G) break;
        __builtin_amdgcn_s_sleep(1);
        if ((++sp & 255u) == 0u) { if (xb_ld(&bar[XB_TMO])) break; if (sp > XB_SPIN_CAP) { atomicAdd(&bar[XB_TMO], 1u); break; } }
    }
    nloc = mine > 0u ? mine : 1u; nx = cnt > 0u ? cnt : 1u;
}

__device__ __forceinline__ void xcd_barrier(const XcdBarrier& b) {
    asm volatile("s_waitcnt vmcnt(0)" ::: "memory");
    __syncthreads();
    if (threadIdx.x == 0) {
        unsigned* bar = b.bar;
        __builtin_amdgcn_s_waitcnt(0);
        unsigned nloc = b.st[0], nx = b.st[1];
        if (nloc == 0u) { xcd_barrier_complete(bar, b.x, nloc, nx); b.st[0] = nloc; b.st[1] = nx; }
        const unsigned old = xb_add(&bar[XB_XSUB(b.x)], 1u);
        const unsigned gen = old / nloc;
        if (old + 1u == (gen + 1u) * nloc) {
            __builtin_amdgcn_fence(__ATOMIC_RELEASE, "agent");
            asm volatile("s_waitcnt vmcnt(0)" ::: "memory");
            const unsigned og = xb_add(&bar[XB_TOP], 1u);
            const unsigned tg = og / nx;
            if (og + 1u == (tg + 1u) * nx) xb_add(&bar[XB_TOPGEN], 1u);
            else XB_SPIN(xb_ld(&bar[XB_TOPGEN]) == tg, bar);
            __builtin_amdgcn_fence(__ATOMIC_ACQUIRE, "agent");
            xb_add(&bar[XB_XGEN(b.x)], 1u);
            asm volatile("s_waitcnt vmcnt(0)" ::: "memory");
        } else {
            XB_SPIN(xb_ld(&bar[XB_XGEN(b.x)]) == gen, bar);
            __builtin_amdgcn_fence(__ATOMIC_ACQUIRE, "agent");
            asm volatile("s_waitcnt vmcnt(0)" ::: "memory");
        }
    }
    __syncthreads();
}

__global__ void __launch_bounds__(NTHREADS, 2) mega_fwd(Args a) {
    extern __shared__ __attribute__((aligned(16))) unsigned char lds_raw[];
    LAS unsigned char* lds = (LAS unsigned char*)lds_raw;
    volatile LAS unsigned* bst = (volatile LAS unsigned*)(lds + LDS_BYTES - 16);
    if (threadIdx.x < 4) bst[threadIdx.x] = 0u;
    __syncthreads();
    const XcdBarrier bar = xcd_barrier_post((unsigned*)(a.ws + WS_CTL), bst);
    unsigned char* ws = a.ws; const int G = gridDim.x, bx = blockIdx.x;
    const int lo = a.ph_lo, hi = a.ph_hi;
#define IN(k) (lo <= (k) && (k) < hi)
#define SEAM(k) do { if (IN((k) + 1)) { xcd_barrier(bar); if (PROBE_DUP & 8) xcd_barrier(bar); } } while (0)
    if (IN(0)) { phase0(a, lds); if (PROBE_DUP & 4) { __syncthreads(); phase0(a, lds); } SEAM(0); }
    if (IN(1)) {
        pg8::Gemm g{(const pg8::bf16_t*)(ws + WS_XN), (const pg8::bf16_t*)(ws + WS_WINT), M, NZ, D}; pg8::StaticOrder S; S.init(M, NZ, G, bx);
        pg8::EpiZ E{(pg8::bf16_t*)(ws + WS_ZRKV), (pg8::bf16_t*)(ws + WS_GATES), (float*)(ws + WS_ZSM)};
        pg8::gemm_phase<pg8::EpiZ, pg8::StaticOrder, true, true>(lds, g, S, E);
        if (PROBE_DUP & 2) pg8::gemm_phase<pg8::EpiZ, pg8::StaticOrder, true, true>(lds, g, S, E);
        SEAM(1);
    }
    if (IN(2)) { phase2(a); SEAM(2); }
    if (IN(3)) {
        pg8::Gemm g{(const pg8::bf16_t*)(ws + WS_QLN), (const pg8::bf16_t*)(ws + WS_WQIT), M, NQI, QR}; pg8::StaticOrder S; S.init(M, NQI, G, bx);
        pg8::EpiBf16Split E{(pg8::bf16_t*)a.out, 4096, 16, (pg8::bf16_t*)(ws + WS_QIDX), 1024};
        pg8::gemm_phase<pg8::EpiBf16Split, pg8::StaticOrder, true, true>(lds, g, S, E);
        SEAM(3);
    }
    if (IN(4)) {
        if (bx < RW_WGS) { rwkv_unit(a, lds, bx >> 4, bx & 15); if (PROBE_DUP & 1) rwkv_unit(a, lds, bx >> 4, bx & 15); }
        else { for (int u = bx - RW_WGS; u < 1024; u += G - RW_WGS) dsa_unit(a, lds, u & 1, 511 - (u >> 1)); }
        SEAM(4);
    }
    if (IN(5)) { for (int u = bx; u < 1024; u += G) uv_unit(a, u >> 4, u & 15); SEAM(5); }
    if (IN(6)) {
        {   pg8::Gemm g{(const pg8::bf16_t*)(ws + WS_XN), (const pg8::bf16_t*)(ws + WS_WOUTT), M, D, D}; pg8::StaticOrder S; S.init(M, D, G, bx);
            pg8::EpiH E{a.in[I_X], a.out, (pg8::bf16_t*)(ws + WS_ZRKV)};
            pg8::gemm_phase<pg8::EpiH, pg8::StaticOrder, true, true>(lds, g, S, E); }
        {   pg8::Gemm g{(const pg8::bf16_t*)(ws + WS_PBF), (const pg8::bf16_t*)(ws + WS_PLEWT), M, D, PLE}; pg8::StaticOrder S; S.init(M, D, G, bx);
            pg8::EpiBf16Split E{(pg8::bf16_t*)(ws + WS_GATES), 2048, 8, (pg8::bf16_t*)(ws + WS_GATES), 2048};
            pg8::gemm_phase<pg8::EpiBf16Split, pg8::StaticOrder, true, true>(lds, g, S, E); }
        SEAM(6);
    }
    if (IN(7)) {
        pg8::Gemm g{(const pg8::bf16_t*)(ws + WS_ZRKV), (const pg8::bf16_t*)(ws + WS_WGATET), M, D, D}; pg8::StaticOrder S; S.init(M, D, G, bx);
        pg8::EpiOut E{a.out, (const pg8::bf16_t*)(ws + WS_GATES), (float*)(ws + WS_PART)};
        pg8::gemm_phase<pg8::EpiOut, pg8::StaticOrder, true, true>(lds, g, S, E);
        SEAM(7);
    }
    if (IN(8)) phase8(a);
}

#ifndef N_LAUNCHES
#define N_LAUNCHES 1
#endif
extern "C" void kernel_launch(void* const* d_in, const int* in_sizes, int n_in, void* d_out, int out_size, void* d_ws, size_t ws_size, hipStream_t stream) {
    static int grid = 0;
    if (grid == 0) {
        int dev = 0, cus = 0, per_cu = 0;
        if (n_in != 26 || out_size != M * D || ws_size < WS_END) { fprintf(stderr, "kernel_launch: unexpected shapes (n_in %d out %d ws %zu)\n", n_in, out_size, ws_size); grid = -1; return; }
        (void)hipGetDevice(&dev); (void)hipDeviceGetAttribute(&cus, hipDeviceAttributeMultiprocessorCount, dev);
        if (hipFuncSetAttribute((const void*)mega_fwd, hipFuncAttributeMaxDynamicSharedMemorySize, LDS_BYTES) != hipSuccess) { fprintf(stderr, "kernel_launch: hipFuncSetAttribute failed\n"); grid = -1; return; }
        if (hipOccupancyMaxActiveBlocksPerMultiprocessor(&per_cu, (const void*)mega_fwd, NTHREADS, LDS_BYTES) != hipSuccess || per_cu < 1) { fprintf(stderr, "kernel_launch: occupancy query says %d\n", per_cu); grid = -1; return; }
        grid = cus;
        fprintf(stderr, "kernel_launch: cus %d per_cu %d grid %d\n", cus, per_cu, grid);
    }
    if (grid < 0) return;
    Args a{};
    for (int i = 0; i < 26; ++i) a.in[i] = (const float*)d_in[i];
    a.out = (float*)d_out; a.ws = (unsigned char*)d_ws;
    const int NPH = 9;
    if (hipMemsetAsync((char*)d_ws + WS_CTL, 0, 16384, stream) != hipSuccess) { fprintf(stderr, "kernel_launch: hipMemsetAsync failed\n"); return; }
    for (int li = 0; li < N_LAUNCHES; ++li) {
        a.ph_lo = (N_LAUNCHES == 1) ? 0 : li; a.ph_hi = (N_LAUNCHES == 1) ? NPH : li + 1;
        void* args[] = {&a};
        const hipError_t e = hipLaunchCooperativeKernel((const void*)mega_fwd, dim3(grid), dim3(NTHREADS), args, LDS_BYTES, stream);
        if (e != hipSuccess) { fprintf(stderr, "kernel_launch: cooperative launch failed: %s (grid %d)\n", hipGetErrorString(e), grid); break; }
    }
}
```

```cpp
#include <hip/hip_runtime.h>
#include <hip/hip_cooperative_groups.h>
#include <cstdio>
#include <cstdint>
namespace cg = cooperative_groups;
#ifndef PROBE_DUP
#define PROBE_DUP 0
#endif
#ifndef PROBE_TS
#define PROBE_TS -1
#endif
#ifndef PROBE_TS2
#define PROBE_TS2 (PROBE_TS + 1)
#endif

namespace pg8 {
#define PG8_LAS __attribute__((address_space(3)))
typedef unsigned short bf16_t;
typedef short bf16x8 __attribute__((ext_vector_type(8)));
typedef float f32x4 __attribute__((ext_vector_type(4)));
typedef unsigned u32x4 __attribute__((ext_vector_type(4)));
constexpr int BM = 256, BK = 64, HALF = 128, HTB = HALF * BK * 2  , STAGE_BYTES = 8 * HTB, NXCD = 8, WGM = 8;

__host__ __device__ __forceinline__ int lds_byte(int r, int c) { const int st = (r >> 4) * 2 + (c >> 5), rr = r & 15, cc = c & 31, ob = rr * 64 + cc * 2; return st * 1024 + (ob ^ (((ob >> 9) & 1) << 5)); }
__host__ __device__ __forceinline__ void stage_rc(int b, int& R, int& C) { const int st = b / 1024, sb = b % 1024, swz = sb ^ (((sb >> 9) & 1) << 5); R = (st >> 1) * 16 + swz / 64; C = (st & 1) * 32 + (swz % 64) / 2; }
__host__ __device__ __forceinline__ int perm32(int rho) { const int n = rho >> 4, i = rho & 15; return 8 * (i >> 2) + 4 * n + (i & 3); }

struct Unit { int pm, pn; };
struct Gemm { const bf16_t* A; const bf16_t* Bt; int M, N, K; };

struct StaticOrder {
    int nM, nN, nwg, G, c;
    __host__ __device__ void init(int M, int N, int G_, int c_) { nM = M / BM; nN = N / BM; nwg = nM * nN; G = G_; c = c_; }
    __host__ __device__ bool next(int i, Unit& u) const {
        const long L = (long)i * G + c; if (L >= nwg) return false;
        int wgid = (int)L; { const int q = nwg / NXCD, r = nwg % NXCD, xcd = wgid % NXCD, off = wgid / NXCD; wgid = (xcd < r ? xcd * (q + 1) : r * (q + 1) + (xcd - r) * q) + off; }
        const int nig = WGM * nN, gid = wgid / nig, fm = gid * WGM, gsz = (nM - fm) < WGM ? (nM - fm) : WGM;
        u.pm = fm + ((wgid % nig) % gsz); u.pn = (wgid % nig) / gsz; return true;
    }
    __device__ __forceinline__ void a_ready(const Unit&) const {}
    __device__ __forceinline__ void done(const Unit&) const {}
};

typedef float f32x2v_t __attribute__((ext_vector_type(2)));
typedef __bf16 bf16x2v_t __attribute__((ext_vector_type(2)));
__device__ __forceinline__ unsigned cvt_pk_bf16(float lo, float hi) { const f32x2v_t v = {lo, hi}; const bf16x2v_t b = __builtin_convertvector(v, bf16x2v_t); return __builtin_bit_cast(unsigned, b); }
__device__ __forceinline__ float silu_f(float v) { return v / (1.0f + __expf(-v)); }
__device__ __forceinline__ float sigmoid_f(float v) { return 1.0f / (1.0f + __expf(-v)); }
__device__ __forceinline__ u32x4 pack8(const f32x4& v0, const f32x4& v1) { u32x4 w; w.x = cvt_pk_bf16(v0[0], v0[1]); w.y = cvt_pk_bf16(v0[2], v0[3]); w.z = cvt_pk_bf16(v1[0], v1[1]); w.w = cvt_pk_bf16(v1[2], v1[3]); return w; }

struct EpiZ {
    static constexpr bool PERM = true, AFTER_DRAIN = false;
    bf16_t* zrkv; bf16_t* gates; float* zsm; bf16_t* qln; float* qss;
    __device__ __forceinline__ void operator()(const f32x4 (&acc)[2][2][4][2], const Unit& u, int wr, int wc, int fr, int fq) const {
        const int row0 = u.pm * BM + wr * 64 + fr, colw = wc * 32 + 8 * fq;
        if (u.pn < 12) {
#pragma unroll
            for (int ai = 0; ai < 2; ++ai)
#pragma unroll
                for (int m = 0; m < 4; ++m) { bf16_t* rowp = zrkv + (size_t)(row0 + ai * HALF + m * 16) * 3072 + u.pn * BM + colw;
#pragma unroll
                    for (int bj = 0; bj < 2; ++bj) *(u32x4*)(rowp + bj * HALF) = pack8(acc[ai][bj][m][0], acc[ai][bj][m][1]); }
        } else if (u.pn < 20) {
#pragma unroll
            for (int ai = 0; ai < 2; ++ai)
#pragma unroll
                for (int m = 0; m < 4; ++m) { bf16_t* rowp = gates + (size_t)(row0 + ai * HALF + m * 16) * 2048 + (u.pn - 12) * BM + colw;
#pragma unroll
                    for (int bj = 0; bj < 2; ++bj) { f32x4 v0 = acc[ai][bj][m][0], v1 = acc[ai][bj][m][1];
#pragma unroll
                        for (int j = 0; j < 4; ++j) { v0[j] = silu_f(v0[j]); v1[j] = silu_f(v1[j]); }
                        *(u32x4*)(rowp + bj * HALF) = pack8(v0, v1); } }
        } else {
#pragma unroll
            for (int ai = 0; ai < 2; ++ai)
#pragma unroll
                for (int m = 0; m < 4; ++m) { float* rowp = zsm + (size_t)(row0 + ai * HALF + m * 16) * 1024 + (u.pn - 20) * BM + colw;
#pragma unroll
                    for (int bj = 0; bj < 2; ++bj) { *(f32x4*)(rowp + bj * HALF) = acc[ai][bj][m][0]; *(f32x4*)(rowp + bj * HALF + 4) = acc[ai][bj][m][1]; } }
            if (u.pn == 20 || u.pn == 21) {
                const int bj0 = (u.pn == 20) ? 1 : 0, qc0 = (u.pn == 20) ? colw - HALF : 128 + colw;
#pragma unroll
                for (int ai = 0; ai < 2; ++ai)
#pragma unroll
                    for (int m = 0; m < 4; ++m) { const int row = row0 + ai * HALF + m * 16; float ss = 0.f;
                        for (int bj = bj0; bj < 2; ++bj) { const f32x4 v0 = acc[ai][bj][m][0], v1 = acc[ai][bj][m][1];
                            ss += v0[0] * v0[0] + v0[1] * v0[1] + v0[2] * v0[2] + v0[3] * v0[3] + v1[0] * v1[0] + v1[1] * v1[1] + v1[2] * v1[2] + v1[3] * v1[3];
                            *(u32x4*)(qln + (size_t)row * 384 + qc0 + bj * HALF) = pack8(v0, v1); }
                        ss += __shfl_xor(ss, 16); ss += __shfl_xor(ss, 32);
                        if (fq == 0) qss[(size_t)row * 8 + (u.pn - 20) * 4 + wc] = ss; }
            }
        }
    }
};
struct EpiBf16Split {
    static constexpr bool PERM = true, AFTER_DRAIN = false;
    bf16_t* O0; int ld0; int nt0; bf16_t* O1; int ld1;
    __device__ __forceinline__ void operator()(const f32x4 (&acc)[2][2][4][2], const Unit& u, int wr, int wc, int fr, int fq) const {
        const int row0 = u.pm * BM + wr * 64 + fr, colw = wc * 32 + 8 * fq;
        bf16_t* base; int ld, ct;
        if (u.pn < nt0) { base = O0; ld = ld0; ct = u.pn; } else { base = O1; ld = ld1; ct = u.pn - nt0; }
#pragma unroll
        for (int ai = 0; ai < 2; ++ai)
#pragma unroll
            for (int m = 0; m < 4; ++m) { bf16_t* rowp = base + (size_t)(row0 + ai * HALF + m * 16) * ld + ct * BM + colw;
#pragma unroll
                for (int bj = 0; bj < 2; ++bj) *(u32x4*)(rowp + bj * HALF) = pack8(acc[ai][bj][m][0], acc[ai][bj][m][1]); }
    }
};
struct EpiH {
    static constexpr bool PERM = true, AFTER_DRAIN = false;
    const float* x; bf16_t* hb;
    __device__ __forceinline__ void operator()(const f32x4 (&acc)[2][2][4][2], const Unit& u, int wr, int wc, int fr, int fq) const {
        const int row0 = u.pm * BM + wr * 64 + fr, col0 = u.pn * BM + wc * 32 + 8 * fq;
#pragma unroll
        for (int ai = 0; ai < 2; ++ai)
#pragma unroll
            for (int m = 0; m < 4; ++m) { const size_t ro = (size_t)(row0 + ai * HALF + m * 16) * 2048 + col0;
#pragma unroll
                for (int bj = 0; bj < 2; ++bj) { const size_t o = ro + bj * HALF;
                    const f32x4 v0 = acc[ai][bj][m][0] + __builtin_nontemporal_load((const f32x4*)(x + o)), v1 = acc[ai][bj][m][1] + __builtin_nontemporal_load((const f32x4*)(x + o + 4));
                    *(u32x4*)(hb + o) = pack8(v0, v1); } }
    }
};
struct EpiOut {
    static constexpr bool PERM = true, AFTER_DRAIN = false;
    float* out; const bf16_t* hb; const bf16_t* ple; float* part;
    __device__ __forceinline__ void operator()(const f32x4 (&acc)[2][2][4][2], const Unit& u, int wr, int wc, int fr, int fq) const {
        const int row0 = u.pm * BM + wr * 64 + fr, col0 = u.pn * BM + wc * 32 + 8 * fq;
#pragma unroll
        for (int ai = 0; ai < 2; ++ai)
#pragma unroll
            for (int m = 0; m < 4; ++m) { const int row = row0 + ai * HALF + m * 16; const size_t ro = (size_t)row * 2048 + col0; float ss = 0.f;
#pragma unroll
                for (int bj = 0; bj < 2; ++bj) { const size_t o = ro + bj * HALF;
                    const u32x4 pw = __builtin_nontemporal_load((const u32x4*)(ple + o)), hw = *(const u32x4*)(hb + o);
                    f32x4 p0, p1, v0, v1;
                    p0[0] = __builtin_bit_cast(float, pw.x << 16); p0[1] = __builtin_bit_cast(float, pw.x & 0xffff0000u); p0[2] = __builtin_bit_cast(float, pw.y << 16); p0[3] = __builtin_bit_cast(float, pw.y & 0xffff0000u);
                    p1[0] = __builtin_bit_cast(float, pw.z << 16); p1[1] = __builtin_bit_cast(float, pw.z & 0xffff0000u); p1[2] = __builtin_bit_cast(float, pw.w << 16); p1[3] = __builtin_bit_cast(float, pw.w & 0xffff0000u);
                    v0[0] = __builtin_bit_cast(float, hw.x << 16); v0[1] = __builtin_bit_cast(float, hw.x & 0xffff0000u); v0[2] = __builtin_bit_cast(float, hw.y << 16); v0[3] = __builtin_bit_cast(float, hw.y & 0xffff0000u);
                    v1[0] = __builtin_bit_cast(float, hw.z << 16); v1[1] = __builtin_bit_cast(float, hw.z & 0xffff0000u); v1[2] = __builtin_bit_cast(float, hw.w << 16); v1[3] = __builtin_bit_cast(float, hw.w & 0xffff0000u);
#pragma unroll
                    for (int j = 0; j < 4; ++j) { v0[j] += p0[j] * sigmoid_f(acc[ai][bj][m][0][j]); v1[j] += p1[j] * sigmoid_f(acc[ai][bj][m][1][j]); ss += v0[j] * v0[j] + v1[j] * v1[j]; }
                    *(f32x4*)(out + o) = v0; *(f32x4*)(out + o + 4) = v1; }
                ss += __shfl_xor(ss, 16); ss += __shfl_xor(ss, 32);
                if (fq == 0) part[(size_t)row * 32 + u.pn * 4 + wc] = ss; }
    }
};

template <class Epi, class Sched, bool ALIGN_EPI = false, bool SP2 = false>
__device__ __forceinline__ void gemm_phase(PG8_LAS unsigned char* lds, const Gemm g, const Sched& S, const Epi& E) {
    const int tid = threadIdx.x, wid = __builtin_amdgcn_readfirstlane(tid >> 6), lane = tid & 63, wr = wid >> 2, wc = wid & 3, fr = lane & 15, fq = lane >> 4;
    const int K = g.K, nt = K / BK;
    unsigned voffA[2], voffB[2];
#pragma unroll
    for (int i = 0; i < 2; ++i) { int R, C; stage_rc(tid * 16 + i * 8192, R, C); const int Rb = Epi::PERM ? ((R & ~31) + perm32(R & 31)) : R;
        voffA[i] = (unsigned)(R * K + C) * 2u; voffB[i] = (unsigned)(Rb * K + C) * 2u; }
    const size_t kstep = (size_t)(BK * 2);
    const size_t hstep = (size_t)HALF * K * 2;
    const size_t tstep = 2 * hstep;
    const unsigned ldsw = (unsigned)wid * 1024u;
    const int aoff = lds_byte(wr * 64 + fr, fq * 8), boff = lds_byte(wc * 32 + fr, fq * 8);
#define PG8_SA(b, h) (((b) * 2 + (h)) * HTB)
#define PG8_SB(b, h) ((4 + (b) * 2 + (h)) * HTB)
#define PG8_STAGE(bufoff, gbase, voff) do { _Pragma("unroll") for (int _i = 0; _i < 2; ++_i) \
        __builtin_amdgcn_global_load_lds((const unsigned*)((const char*)(gbase) + (voff)[_i]), (PG8_LAS unsigned*)(lds + (bufoff) + ldsw + _i * 8192), 16, 0, 0); } while (0)
#define PG8_LDA(dst, b, h) do { _Pragma("unroll") for (int m = 0; m < 4; ++m) _Pragma("unroll") for (int k = 0; k < 2; ++k) dst[m][k] = *(const PG8_LAS bf16x8*)(lds + PG8_SA(b, h) + aoff + m * 2048 + k * 1024); } while (0)
#define PG8_LDB(dst, b, h) do { _Pragma("unroll") for (int n = 0; n < 2; ++n) _Pragma("unroll") for (int k = 0; k < 2; ++k) dst[n][k] = *(const PG8_LAS bf16x8*)(lds + PG8_SB(b, h) + boff + n * 2048 + k * 1024); } while (0)
#define PG8_MMA(ai, bj, At, Bt) do { __builtin_amdgcn_s_setprio(1); _Pragma("unroll") for (int m = 0; m < 4; ++m) _Pragma("unroll") for (int n = 0; n < 2; ++n) _Pragma("unroll") for (int k = 0; k < 2; ++k) \
        acc[ai][bj][m][n] = __builtin_amdgcn_mfma_f32_16x16x32_bf16(Bt[n][k], At[m][k], acc[ai][bj][m][n], 0, 0, 0); __builtin_amdgcn_s_setprio(0); } while (0)
#define PG8_WAIT_V(n) asm volatile("s_waitcnt vmcnt(" #n ")" ::: "memory")
#define PG8_WAIT_L(n) asm volatile("s_waitcnt lgkmcnt(" #n ")" ::: "memory")
#define PG8_BAR __builtin_amdgcn_s_barrier()
#define PG8_SCHED __builtin_amdgcn_sched_barrier(0)
    Unit cur, nxt; int ui = 0;
    if (!S.next(0, cur)) return;
    f32x4 acc[2][2][4][2];
#pragma unroll
    for (int a = 0; a < 2; ++a)
#pragma unroll
        for (int b = 0; b < 2; ++b)
#pragma unroll
            for (int m = 0; m < 4; ++m)
#pragma unroll
                for (int n = 0; n < 2; ++n) acc[a][b][m][n] = (f32x4){0.f, 0.f, 0.f, 0.f};
    bf16x8 At[4][2], B0[2][2], B1[2][2];
    const char* cA = (const char*)g.A + (size_t)cur.pm * tstep; const char* cB = (const char*)g.Bt + (size_t)cur.pn * tstep;
    S.a_ready(cur);
    if constexpr (SP2) {
        PG8_STAGE(PG8_SB(0, 0), cB, voffB); PG8_STAGE(PG8_SB(0, 1), cB + hstep, voffB); PG8_STAGE(PG8_SA(0, 0), cA, voffA); PG8_STAGE(PG8_SA(0, 1), cA + hstep, voffA);
        if (wr == 1) PG8_BAR;
        PG8_WAIT_V(2); PG8_BAR;
        PG8_STAGE(PG8_SB(1, 0), cB + kstep, voffB); PG8_STAGE(PG8_SA(1, 0), cA + kstep, voffA); PG8_STAGE(PG8_SB(1, 1), cB + hstep + kstep, voffB);
        PG8_WAIT_V(6); PG8_BAR;
    } else {
        PG8_STAGE(PG8_SB(0, 0), cB, voffB); PG8_STAGE(PG8_SA(0, 0), cA, voffA); PG8_STAGE(PG8_SB(0, 1), cB + hstep, voffB); PG8_STAGE(PG8_SA(0, 1), cA + hstep, voffA);
        if (wr == 1) PG8_BAR;
        PG8_WAIT_V(4); PG8_BAR;
        PG8_STAGE(PG8_SB(1, 0), cB + kstep, voffB); PG8_STAGE(PG8_SA(1, 0), cA + kstep, voffA); PG8_STAGE(PG8_SB(1, 1), cB + hstep + kstep, voffB);
        PG8_WAIT_V(6); PG8_BAR;
    }
    for (;;) {
        const bool has_next = S.next(ui + 1, nxt);
        const char* nA = has_next ? (const char*)g.A + (size_t)nxt.pm * tstep : cA; const char* nB = has_next ? (const char*)g.Bt + (size_t)nxt.pn * tstep : cB;
        for (int t = 0; t < nt; t += 2) {
            const bool last = (t == nt - 2);
            const char* a1 = cA + (size_t)(t + 1) * kstep;
            const char* a2 = last ? nA : cA + (size_t)(t + 2) * kstep; const char* b2 = last ? nB : cB + (size_t)(t + 2) * kstep;
            const char* a3 = a2 + kstep; const char* b3 = b2 + kstep;
            if (last && has_next) S.a_ready(nxt);
            if constexpr (SP2) {
            PG8_LDB(B0, 0, 0); PG8_LDB(B1, 0, 1); PG8_SCHED; PG8_LDA(At, 0, 0); PG8_STAGE(PG8_SA(1, 1), a1 + hstep, voffA);
            PG8_WAIT_V(8); PG8_WAIT_L(0); PG8_BAR; PG8_MMA(0, 0, At, B0); PG8_MMA(0, 1, At, B1); PG8_BAR; PG8_SCHED;
            PG8_LDA(At, 0, 1); PG8_STAGE(PG8_SB(0, 0), b2, voffB); PG8_STAGE(PG8_SB(0, 1), b2 + hstep, voffB); PG8_STAGE(PG8_SA(0, 0), a2, voffA);
            PG8_WAIT_V(8); PG8_WAIT_L(0); PG8_BAR; PG8_MMA(1, 0, At, B0); PG8_MMA(1, 1, At, B1); PG8_BAR; PG8_SCHED;
            PG8_LDB(B0, 1, 0); PG8_LDB(B1, 1, 1); PG8_SCHED; PG8_LDA(At, 1, 0); PG8_STAGE(PG8_SA(0, 1), a2 + hstep, voffA);
            PG8_WAIT_V(8); PG8_WAIT_L(0); PG8_BAR; PG8_MMA(0, 0, At, B0); PG8_MMA(0, 1, At, B1); PG8_BAR; PG8_SCHED;
            PG8_LDA(At, 1, 1); PG8_STAGE(PG8_SB(1, 0), b3, voffB); PG8_STAGE(PG8_SB(1, 1), b3 + hstep, voffB); PG8_STAGE(PG8_SA(1, 0), a3, voffA);
            PG8_WAIT_V(8); PG8_WAIT_L(0); PG8_BAR; PG8_MMA(1, 0, At, B0); PG8_MMA(1, 1, At, B1); PG8_BAR; PG8_SCHED;
            } else {
            PG8_LDB(B0, 0, 0); PG8_SCHED; PG8_LDA(At, 0, 0); PG8_STAGE(PG8_SA(1, 1), a1 + hstep, voffA);
            PG8_WAIT_L(8); PG8_BAR; PG8_WAIT_L(0); PG8_MMA(0, 0, At, B0); PG8_BAR; PG8_SCHED;
            PG8_LDB(B1, 0, 1); PG8_STAGE(PG8_SB(0, 0), b2, voffB);
            PG8_BAR; PG8_WAIT_L(0); PG8_MMA(0, 1, At, B1); PG8_BAR;
            PG8_LDA(At, 0, 1); PG8_STAGE(PG8_SA(0, 0), a2, voffA);
            PG8_BAR; PG8_WAIT_L(0); PG8_MMA(1, 0, At, B0); PG8_BAR; PG8_SCHED;
            PG8_STAGE(PG8_SB(0, 1), b2 + hstep, voffB);
            PG8_WAIT_V(6); PG8_BAR; PG8_MMA(1, 1, At, B1); PG8_BAR;
            PG8_LDB(B0, 1, 0); PG8_SCHED; PG8_LDA(At, 1, 0); PG8_STAGE(PG8_SA(0, 1), a2 + hstep, voffA);
            PG8_WAIT_L(8); PG8_BAR; PG8_WAIT_L(0); PG8_MMA(0, 0, At, B0); PG8_BAR; PG8_SCHED;
            PG8_LDB(B1, 1, 1); PG8_STAGE(PG8_SB(1, 0), b3, voffB);
            PG8_BAR; PG8_WAIT_L(0); PG8_MMA(0, 1, At, B1); PG8_BAR;
            PG8_LDA(At, 1, 1); PG8_STAGE(PG8_SA(1, 0), a3, voffA);
            PG8_BAR; PG8_WAIT_L(0); PG8_MMA(1, 0, At, B0); PG8_BAR; PG8_SCHED;
            PG8_STAGE(PG8_SB(1, 1), b3 + hstep, voffB);
            PG8_WAIT_V(6); PG8_BAR; PG8_MMA(1, 1, At, B1); PG8_BAR;
            }
        }
        if constexpr (ALIGN_EPI) { if (wr == 0) PG8_BAR; }
        if constexpr (!Epi::AFTER_DRAIN) { E(acc, cur, wr, wc, fr, fq); S.done(cur); }
        if (!has_next) break;
#pragma unroll
        for (int a = 0; a < 2; ++a)
#pragma unroll
            for (int b = 0; b < 2; ++b)
#pragma unroll
                for (int m = 0; m < 4; ++m)
#pragma unroll
                    for (int n = 0; n < 2; ++n) acc[a][b][m][n] = (f32x4){0.f, 0.f, 0.f, 0.f};
        cur = nxt; cA = nA; cB = nB; ++ui;
        if constexpr (ALIGN_EPI) { if (wr == 1) PG8_BAR; }
    }
    PG8_WAIT_V(0);
    if constexpr (!ALIGN_EPI) { if (wr == 0) PG8_BAR; }
    PG8_BAR;
    if constexpr (Epi::AFTER_DRAIN) { E.fused(acc, cur, wr, wc, fr, fq, lds, wid, lane); S.done(cur); }
#undef PG8_SA
#undef PG8_SB
#undef PG8_STAGE
#undef PG8_LDA
#undef PG8_LDB
#undef PG8_MMA
#undef PG8_WAIT_V
#undef PG8_WAIT_L
#undef PG8_BAR
#undef PG8_SCHED
}
}

constexpr int NB = 2, T = 4096, M = NB * T, D = 2048, DIN = 5968, NZ = 6144, PLE = 256;
constexpr int QR = 384, KVR = 256, NQI = 5120;
constexpr int NWAVES = 8, NTHREADS = 512;
constexpr int LDS_BYTES = 163840;
constexpr int RW_WGS = 32;
constexpr size_t MiB = 1u << 20;
constexpr size_t WS_CTL = 0;
constexpr size_t WS_WINT = 1 * MiB;
constexpr size_t WS_WOUTT = 25 * MiB;
constexpr size_t WS_WGATET = 33 * MiB;
constexpr size_t WS_PLEWT = 41 * MiB;
constexpr size_t WS_WQIT = 42 * MiB;
constexpr size_t WS_WUVT = 46 * MiB;
constexpr size_t WS_PBF = 47 * MiB;
constexpr size_t WS_XN = 51 * MiB;
constexpr size_t WS_ZRKV = 83 * MiB;
constexpr size_t WS_GATES = 131 * MiB;
constexpr size_t WS_ZSM = 163 * MiB;
constexpr size_t WS_QLN = 195 * MiB;
constexpr size_t WS_CKV = 201 * MiB;
constexpr size_t WS_KIDX = 205 * MiB;
constexpr size_t WS_WIDX = 206 * MiB;
constexpr size_t WS_QIDX = 207 * MiB;
constexpr size_t WS_PART = 223 * MiB;
constexpr size_t WS_RWR = 1 * MiB;
constexpr size_t WS_QRI = 19 * MiB;
constexpr size_t WS_QSS = 18 * MiB;
constexpr size_t WS_RBC = 17 * MiB;
constexpr size_t WS_RG = 224 * MiB;
constexpr size_t WS_RSL = 240 * MiB;
constexpr size_t WS_END = 256 * MiB;
constexpr size_t CTL_QUEUE = 15872;
constexpr int ZS_WD = 0, ZS_AD = 64, ZS_QL = 128, ZS_KV = 512, ZS_KI = 768, ZS_WI = 832;
#define YLOC_OFF(h_) ((h_) < 12 ? 512 + (h_) * 128 : 3392 + ((h_) - 12) * 128)

#define LAS __attribute__((address_space(3)))
typedef unsigned short bf16;
typedef float f32x4 __attribute__((ext_vector_type(4)));
typedef float f32x16 __attribute__((ext_vector_type(16)));
typedef short bf16x8 __attribute__((ext_vector_type(8)));
typedef short s16x4 __attribute__((ext_vector_type(4)));
typedef unsigned u32x4 __attribute__((ext_vector_type(4)));
typedef unsigned u32x2 __attribute__((ext_vector_type(2)));

__device__ __forceinline__ unsigned f2bf(float f) { unsigned u = __builtin_bit_cast(unsigned, f); return (u + 0x7fffu + ((u >> 16) & 1u)) >> 16; }
typedef float f32x2_t __attribute__((ext_vector_type(2)));
typedef __bf16 bf16x2_t __attribute__((ext_vector_type(2)));
__device__ __forceinline__ unsigned pk2(float lo, float hi) { const f32x2_t v = {lo, hi}; const bf16x2_t b = __builtin_convertvector(v, bf16x2_t); return __builtin_bit_cast(unsigned, b); }
__device__ __forceinline__ float bflo(unsigned w) { return __builtin_bit_cast(float, w << 16); }
__device__ __forceinline__ float bfhi(unsigned w) { return __builtin_bit_cast(float, w & 0xffff0000u); }
__device__ __forceinline__ float bf1(bf16 v) { return __builtin_bit_cast(float, (unsigned)v << 16); }
#define LDS_BARRIER() do { asm volatile("s_waitcnt lgkmcnt(0)" ::: "memory"); __builtin_amdgcn_s_barrier(); asm volatile("" ::: "memory"); } while (0)
template <int CTRL> __device__ __forceinline__ float dppf(float x) { return __builtin_bit_cast(float, __builtin_amdgcn_update_dpp(0, __builtin_bit_cast(int, x), CTRL, 0xF, 0xF, true)); }
__device__ __forceinline__ float allsum8(float x) { x += dppf<0xB1>(x); x += dppf<0x4E>(x); x += dppf<0x141>(x); return x; }
__device__ __forceinline__ float allsum16(float x) { x = allsum8(x); x += dppf<0x140>(x); return x; }
__device__ __forceinline__ float allmax16(float x) { x = fmaxf(x, dppf<0xB1>(x)); x = fmaxf(x, dppf<0x4E>(x)); x = fmaxf(x, dppf<0x141>(x)); x = fmaxf(x, dppf<0x140>(x)); return x; }
__device__ __forceinline__ float wave_sum(float v) {
#pragma unroll
    for (int o = 1; o < 64; o <<= 1) v += __shfl_xor(v, o);
    return v;
}

struct Args { const float* in[26]; float* out; unsigned char* ws; int ph_lo, ph_hi; };
enum { I_X = 0, I_P, I_WIN, I_NORMG, I_MU, I_W0, I_WUP, I_A0, I_AUP, I_KK, I_KA, I_RK, I_LNG, I_LNB, I_QNG, I_KVNG, I_IKNG, I_WUQ, I_WUK, I_WUV, I_IWQ, I_RELB, I_WOUT, I_PLEW, I_WGATE, I_FINALG };

__device__ __forceinline__ int win_src_col(int n) {
    if (n < 3072) return n;
    if (n < 4096) return n - 3072 + 3200;
    if (n < 5120) return n - 4096 + 4944;
    if (n < 5248) return n - 5120 + 3072;
    if (n < 5632) return n - 5248 + 4224;
    if (n < 5888) return n - 5632 + 4608;
    if (n < 5952) return n - 5888 + 4864;
    if (n < 5968) return n - 5952 + 4928;
    return -1;
}
struct TrTile { const float* src; bf16* dst; const float* kscale; int ldsrc, K, n0, k0, sc; };
constexpr int TR_WIN = (NZ / 64) * (D / 64), TR_CRIT = (NZ / 64) * (D / 64) + (1024 / 64) * (QR / 64), TR_TOTAL = TR_CRIT + 2 * (D / 64) * (D / 64) + (D / 64) * (PLE / 64) + (1024 / 64) * (KVR / 64), TR_S1 = TR_CRIT + (TR_TOTAL - TR_CRIT) / 3, TR_S2 = TR_CRIT + 2 * (TR_TOTAL - TR_CRIT) / 3;
__device__ __forceinline__ bool tr_item(const Args& a, int it, int hi, int tid, TrTile& t) {
    unsigned char* ws = a.ws;
    const int n_win = (NZ / 64) * (D / 64), n_sq = (D / 64) * (D / 64), n_ple = (D / 64) * (PLE / 64), n_iwq = (1024 / 64) * (QR / 64), n_wuv = (1024 / 64) * (KVR / 64);
    const int total = n_win + 2 * n_sq + n_ple + n_iwq + n_wuv;
    if (it >= hi || it >= total) return false;
    int nt, kt; bool win = false; t.kscale = nullptr;
    if (it < n_win) { t.src = a.in[I_WIN]; t.ldsrc = DIN; t.K = D; t.dst = (bf16*)(ws + WS_WINT); nt = it / (D / 64); kt = it % (D / 64); win = true; }
    else if ((it -= n_win) < n_iwq) { t.src = a.in[I_IWQ]; t.ldsrc = 1024; t.K = QR; t.dst = (bf16*)(ws + WS_WQIT) + (size_t)4096 * QR; nt = it / (QR / 64); kt = it % (QR / 64); t.kscale = a.in[I_QNG]; }
    else if ((it -= n_iwq) < n_sq) { t.src = a.in[I_WOUT]; t.ldsrc = D; t.K = D; t.dst = (bf16*)(ws + WS_WOUTT); nt = it / (D / 64); kt = it % (D / 64); }
    else if ((it -= n_sq) < n_sq) { t.src = a.in[I_WGATE]; t.ldsrc = D; t.K = D; t.dst = (bf16*)(ws + WS_WGATET); nt = it / (D / 64); kt = it % (D / 64); }
    else if ((it -= n_sq) < n_ple) { t.src = a.in[I_PLEW]; t.ldsrc = D; t.K = PLE; t.dst = (bf16*)(ws + WS_PLEWT); nt = it / (PLE / 64); kt = it % (PLE / 64); }
    else { it -= n_ple; t.src = a.in[I_WUV]; t.ldsrc = 1024; t.K = KVR; t.dst = (bf16*)(ws + WS_WUVT); nt = it / (KVR / 64); kt = it % (KVR / 64); }
    t.n0 = nt * 64; t.k0 = kt * 64; const int c4 = (tid & 15) * 4; t.sc = win ? win_src_col(t.n0 + c4) : (t.n0 + c4);
    return true;
}
__device__ __forceinline__ void tr_load(const TrTile& t, int tid, f32x4& v0, f32x4& v1) {
    const int kr = tid >> 4; v0 = (f32x4){0.f, 0.f, 0.f, 0.f}; v1 = v0;
    if (t.sc >= 0) { v0 = *(const f32x4*)(t.src + (size_t)(t.k0 + kr) * t.ldsrc + t.sc); v1 = *(const f32x4*)(t.src + (size_t)(t.k0 + kr + 32) * t.ldsrc + t.sc); }
}

__device__ __forceinline__ void tr_run(const Args& a, LAS unsigned char* lds, int lo, int hi) {
    const int tid = threadIdx.x, G = gridDim.x, bx = blockIdx.x; LAS float* scr = (LAS float*)lds;
    {   TrTile cur, nxt; f32x4 v0, v1, n0v, n1v; int item = lo + bx, par = 0;
        bool have = tr_item(a, item, hi, tid, cur);
        if (have) tr_load(cur, tid, v0, v1);
        while (have) {
            item += G; const bool hn = tr_item(a, item, hi, tid, nxt);
            if (hn) tr_load(nxt, tid, n0v, n1v);
            LAS float* sb = scr + par * (64 * 65); par ^= 1;
            { const int kr = tid >> 4, c4 = (tid & 15) * 4;
              sb[kr * 65 + c4 + 0] = v0[0]; sb[kr * 65 + c4 + 1] = v0[1]; sb[kr * 65 + c4 + 2] = v0[2]; sb[kr * 65 + c4 + 3] = v0[3];
              sb[(kr + 32) * 65 + c4 + 0] = v1[0]; sb[(kr + 32) * 65 + c4 + 1] = v1[1]; sb[(kr + 32) * 65 + c4 + 2] = v1[2]; sb[(kr + 32) * 65 + c4 + 3] = v1[3]; }
            LDS_BARRIER();
            { const int n = tid >> 3, kq = (tid & 7) * 8; float v[8];
#pragma unroll
              for (int j = 0; j < 8; ++j) v[j] = sb[(kq + j) * 65 + n];
              if (cur.kscale) {
#pragma unroll
                  for (int j = 0; j < 8; ++j) v[j] *= cur.kscale[cur.k0 + kq + j]; }
              u32x4 wv; wv.x = pk2(v[0], v[1]); wv.y = pk2(v[2], v[3]); wv.z = pk2(v[4], v[5]); wv.w = pk2(v[6], v[7]);
              *(u32x4*)(cur.dst + (size_t)(cur.n0 + n) * cur.K + cur.k0 + kq) = wv; }
            cur = nxt; v0 = n0v; v1 = n1v; have = hn;
        }
        LDS_BARRIER();
    }
}

__device__ __forceinline__ void p_to_bf16(const Args& a) {
    const int tid = threadIdx.x, G = gridDim.x, bx = blockIdx.x; unsigned char* ws = a.ws;
    {   const float* p = a.in[I_P]; bf16* pb = (bf16*)(ws + WS_PBF);
        for (int i = bx * NTHREADS + tid; i < M * PLE / 4; i += G * NTHREADS) { const f32x4 v = *(const f32x4*)(p + (size_t)i * 4); u32x2 w; w.x = pk2(v[0], v[1]); w.y = pk2(v[2], v[3]); *(u32x2*)(pb + (size_t)i * 4) = w; }
    }
}

__device__ __forceinline__ void wfold_prep(const Args& a) {
    const int tid = threadIdx.x, lane = tid & 63, wave = tid >> 6, G = gridDim.x, bx = blockIdx.x; unsigned char* ws = a.ws;
    {   const float* wuq = a.in[I_WUQ]; const float* wuk = a.in[I_WUK]; bf16* wq = (bf16*)(ws + WS_WQIT);
        const int i = lane & 31, half = lane >> 5;
        for (int u = G - 1 - bx; u < 128; u += G) { const int h = u >> 3, rblk = u & 7;
            bf16x8 af[4];
#pragma unroll
            for (int ks = 0; ks < 4; ++ks) { const float* pa = wuk + (size_t)(rblk * 32 + i) * 1024 + h * 64 + ks * 16 + half * 8; const f32x4 x0 = *(const f32x4*)pa, x1 = *(const f32x4*)(pa + 4);
                u32x4 wv; wv.x = pk2(x0[0], x0[1]); wv.y = pk2(x0[2], x0[3]); wv.z = pk2(x1[0], x1[1]); wv.w = pk2(x1[2], x1[3]); af[ks] = __builtin_bit_cast(bf16x8, wv); }
            for (int kblk = wave; kblk < QR / 32; kblk += NWAVES) { f32x16 acc; const float gqk = 0.125f * a.in[I_QNG][kblk * 32 + i];
#pragma unroll
                for (int j = 0; j < 16; ++j) acc[j] = 0.f;
#pragma unroll
                for (int ks = 0; ks < 4; ++ks) { const float* pb = wuq + (size_t)(kblk * 32 + i) * 1024 + h * 64 + ks * 16 + half * 8; const f32x4 x0 = *(const f32x4*)pb, x1 = *(const f32x4*)(pb + 4);
                    u32x4 wv; wv.x = pk2(x0[0], x0[1]); wv.y = pk2(x0[2], x0[3]); wv.z = pk2(x1[0], x1[1]); wv.w = pk2(x1[2], x1[3]);
                    acc = __builtin_amdgcn_mfma_f32_32x32x16_bf16(af[ks], __builtin_bit_cast(bf16x8, wv), acc, 0, 0, 0); }
#pragma unroll
                for (int r = 0; r < 16; ++r) { const int rr = (r & 3) + 8 * (r >> 2) + 4 * half; wq[(size_t)(h * 256 + rblk * 32 + rr) * QR + kblk * 32 + i] = (bf16)f2bf(acc[r] * gqk); }
            }
        }
    }
}

__device__ __forceinline__ void phase0(const Args& a, LAS unsigned char* lds) {
    const int tid = threadIdx.x, lane = tid & 63, wave = tid >> 6, G = gridDim.x, bx = blockIdx.x;
    unsigned char* ws = a.ws; LAS float* scr = (LAS float*)lds;
    tr_run(a, lds, 0, TR_WIN);
    {   const float* x = a.in[I_X]; const float* g = a.in[I_NORMG]; bf16* xn = (bf16*)(ws + WS_XN);
        int row = bx * NWAVES + wave; f32x4 v[8], vn[8];
        if (row < M) {
#pragma unroll
            for (int i = 0; i < 8; ++i) v[i] = *(const f32x4*)(x + (size_t)row * D + (i * 64 + lane) * 4);
        }
        for (; row < M; row += G * NWAVES) {
            const int rown = row + G * NWAVES;
            if (rown < M) {
#pragma unroll
                for (int i = 0; i < 8; ++i) vn[i] = *(const f32x4*)(x + (size_t)rown * D + (i * 64 + lane) * 4);
            }
            float ss = 0.f;
#pragma unroll
            for (int i = 0; i < 8; ++i) ss += v[i][0] * v[i][0] + v[i][1] * v[i][1] + v[i][2] * v[i][2] + v[i][3] * v[i][3];
            ss = wave_sum(ss); const float r = rsqrtf(ss * (1.0f / D) + 1e-6f);
#pragma unroll
            for (int i = 0; i < 8; ++i) { const f32x4 gg = *(const f32x4*)(g + (i * 64 + lane) * 4); u32x2 w; w.x = pk2(v[i][0] * r * gg[0], v[i][1] * r * gg[1]); w.y = pk2(v[i][2] * r * gg[2], v[i][3] * r * gg[3]);
                *(u32x2*)(xn + (size_t)row * D + (i * 64 + lane) * 4) = w; }
#pragma unroll
            for (int i = 0; i < 8; ++i) v[i] = vn[i];
        }
    }
}

__device__ __forceinline__ void phase2(const Args& a, int bx, int G) {
    const int tid = threadIdx.x, lane = tid & 63, wave = tid >> 6;
    unsigned char* ws = a.ws; const float* zsm = (const float*)(ws + WS_ZSM);
    bf16* qln = (bf16*)(ws + WS_QLN); bf16* ckv = (bf16*)(ws + WS_CKV); bf16* kidx = (bf16*)(ws + WS_KIDX); float* widx = (float*)(ws + WS_WIDX);
    const float* gq = a.in[I_QNG]; const float* gkv = a.in[I_KVNG]; const float* gik = a.in[I_IKNG];
    for (int row = bx * NWAVES + wave; row < M; row += G * NWAVES) {
        const float* zr = zsm + (size_t)row * 1024;
        { const f32x4 v = *(const f32x4*)(zr + ZS_KV + lane * 4); float ss = v[0] * v[0] + v[1] * v[1] + v[2] * v[2] + v[3] * v[3];
          ss = wave_sum(ss); const float r = rsqrtf(ss * (1.0f / KVR) + 1e-6f); const f32x4 gg = *(const f32x4*)(gkv + lane * 4);
          u32x2 w; w.x = pk2(v[0] * r * gg[0], v[1] * r * gg[1]); w.y = pk2(v[2] * r * gg[2], v[3] * r * gg[3]); *(u32x2*)(ckv + (size_t)row * KVR + lane * 4) = w; }
        { const float v = zr[ZS_KI + lane]; float ss = wave_sum(v * v); const float r = rsqrtf(ss * (1.0f / 64) + 1e-6f);
          kidx[((((size_t)row >> 5) * 4 + (lane >> 4)) * 64 + ((lane >> 3) & 1) * 32 + (row & 31)) * 8 + (lane & 7)] = (bf16)f2bf(v * r * gik[lane]); }
        if (lane < 16) widx[(size_t)row * 16 + lane] = zr[ZS_WI + lane] * (1.0f / 32.0f);
    }
}

constexpr int RC_WUP = 0, RC_AUP = 9216, RC_S0 = 18432, RC_AT = 27648, RC_RT = 36864, RC_BT = 46080, RC_KT = 55296, RC_VT = 64512, RC_XA = 73728, RC_XB = 82944, RC_TA = 92160, RC_TB = 101376,
              RC_MAK = 110592, RC_NRB = 119808, RC_NRK = 129024, RC_VEC = 138240, RC_CST = 139008;
constexpr int RC_WPRE = RC_XA, RC_APRE = RC_TA, RC_LW = RC_MAK, RC_TOT = RC_NRK, RC_WDT = RC_AT, RC_ADT = RC_RT, RC_YF = RC_XA;
constexpr int MP = 144, FP = 272;
__device__ __forceinline__ float softplus_f(float x) { return fmaxf(x, 0.f) + __logf(1.0f + __expf(-fabsf(x))); }
__device__ __forceinline__ float tanh_fast(float x) { const float e = __expf(2.0f * x); return 1.0f - 2.0f * __builtin_amdgcn_rcpf(1.0f + e); }
__device__ __forceinline__ bf16x8 ld_contig(LAS const unsigned char* Mx, int row, int k0) { return *(LAS const bf16x8*)(Mx + row * MP + k0 * 2); }
__device__ __forceinline__ bf16x8 ld_tr(LAS const unsigned char* Mx, int krow0, int col0, int q, int p) {
    LAS const unsigned char* base = Mx + (krow0 + q) * MP + (col0 + 4 * p) * 2;
    const s16x4 lo = __builtin_amdgcn_ds_read_tr16_b64_v4i16((LAS s16x4*)(base));
    const s16x4 hi = __builtin_amdgcn_ds_read_tr16_b64_v4i16((LAS s16x4*)(base + 4 * MP));
    return (bf16x8){lo[0], lo[1], lo[2], lo[3], hi[0], hi[1], hi[2], hi[3]};
}
template <bool A_TR, bool B_TR> __device__ __forceinline__ void mm_acc(f32x16& acc, LAS const unsigned char* A, LAS const unsigned char* B, int rb, int cb, int lane) {
    const int l31 = lane & 31, kh = lane >> 5, q = (lane & 15) >> 2, p = lane & 3, cblk = ((lane >> 4) & 1) * 16;
#pragma unroll
    for (int ks = 0; ks < 4; ++ks) { const int k0 = ks * 16 + 8 * kh;
        const bf16x8 qf = A_TR ? ld_tr(A, k0, 32 * rb + cblk, q, p) : ld_contig(A, 32 * rb + l31, k0);
        const bf16x8 pf = B_TR ? ld_tr(B, k0, 32 * cb + cblk, q, p) : ld_contig(B, 32 * cb + l31, k0);
        acc = __builtin_amdgcn_mfma_f32_32x32x16_bf16(pf, qf, acc, 0, 0, 0); }
}
__device__ __forceinline__ void st_tile_bf16(LAS unsigned char* Dm, const f32x16& acc, int rb, int cb, int lane) {
    LAS unsigned char* rowp = Dm + (32 * rb + (lane & 31)) * MP + (32 * cb + 4 * (lane >> 5)) * 2;
#pragma unroll
    for (int g = 0; g < 4; ++g) { u32x2 w; w.x = pk2(acc[4 * g], acc[4 * g + 1]); w.y = pk2(acc[4 * g + 2], acc[4 * g + 3]); *(LAS u32x2*)(rowp + 16 * g) = w; }
}
__device__ __forceinline__ void st_tile_f32(LAS unsigned char* Dm, const f32x16& acc, int rb, int cb, int lane) {
    LAS unsigned char* rowp = Dm + (32 * rb + (lane & 31)) * FP + (32 * cb + 4 * (lane >> 5)) * 4;
#pragma unroll
    for (int g = 0; g < 4; ++g) *(LAS f32x4*)(rowp + 32 * g) = (f32x4){acc[4 * g], acc[4 * g + 1], acc[4 * g + 2], acc[4 * g + 3]};
}
template <bool INCL> __device__ __forceinline__ void mask_tril(f32x16& acc, int rb, int cb, int lane) {
    const int row = 32 * rb + (lane & 31);
#pragma unroll
    for (int j = 0; j < 16; ++j) { const int col = 32 * cb + (j & 3) + 8 * (j >> 2) + 4 * (lane >> 5); if (INCL ? (col > row) : (col >= row)) acc[j] = 0.f; }
}
__device__ __forceinline__ f32x16 zero16() { f32x16 z;
#pragma unroll
    for (int j = 0; j < 16; ++j) z[j] = 0.f;
    return z; }

__device__ __forceinline__ void st_tile_bf16_g(bf16* Dm, int pitch, const f32x16& acc, int rb, int cb, int lane) {
    bf16* rowp = Dm + (size_t)(32 * rb + (lane & 31)) * pitch + 32 * cb + 4 * (lane >> 5);
#pragma unroll
    for (int g = 0; g < 4; ++g) { u32x2 w; w.x = pk2(acc[4 * g], acc[4 * g + 1]); w.y = pk2(acc[4 * g + 2], acc[4 * g + 3]); *(u32x2*)(rowp + 8 * g) = w; }
}
__device__ __forceinline__ f32x16 ld_tile_bf16_g(const bf16* Dm, int pitch, int rb, int cb, int lane) {
    const bf16* rowp = Dm + (size_t)(32 * rb + (lane & 31)) * pitch + 32 * cb + 4 * (lane >> 5); f32x16 r;
#pragma unroll
    for (int g = 0; g < 4; ++g) { const u32x2 w = *(const u32x2*)(rowp + 8 * g); r[4 * g] = bflo(w.x); r[4 * g + 1] = bfhi(w.x); r[4 * g + 2] = bflo(w.y); r[4 * g + 3] = bfhi(w.y); }
    return r;
}
__device__ __forceinline__ void rwkvA_phase(const Args& a, LAS unsigned char* lds, int h, int p0, int pstep) {
    const int tid = threadIdx.x, lane = tid & 63, w = __builtin_amdgcn_readfirstlane(tid >> 6);
    unsigned char* ws = a.ws;
    const bf16* zrkv = (const bf16*)(ws + WS_ZRKV); const float* zsm = (const float*)(ws + WS_ZSM);
    for (int i = tid; i < 64 * 8; i += NTHREADS) { const int r = i >> 3, c = (i & 7) * 8;
        const f32x4 w0v = *(const f32x4*)(a.in[I_WUP] + (size_t)r * 1024 + h * 64 + c), w1v = *(const f32x4*)(a.in[I_WUP] + (size_t)r * 1024 + h * 64 + c + 4);
        const f32x4 a0v = *(const f32x4*)(a.in[I_AUP] + (size_t)r * 1024 + h * 64 + c), a1v = *(const f32x4*)(a.in[I_AUP] + (size_t)r * 1024 + h * 64 + c + 4);
        u32x4 pw; pw.x = pk2(w0v[0], w0v[1]); pw.y = pk2(w0v[2], w0v[3]); pw.z = pk2(w1v[0], w1v[1]); pw.w = pk2(w1v[2], w1v[3]);
        u32x4 pa; pa.x = pk2(a0v[0], a0v[1]); pa.y = pk2(a0v[2], a0v[3]); pa.z = pk2(a1v[0], a1v[1]); pa.w = pk2(a1v[2], a1v[3]);
        *(LAS u32x4*)(lds + RC_WUP + r * MP + c * 2) = pw; *(LAS u32x4*)(lds + RC_AUP + r * MP + c * 2) = pa; }
    const int pt = tid >> 3, c8 = (tid & 7) * 8, ch = h * 64 + c8;
    if (tid < 64) { LAS float* cst = (LAS float*)(lds + RC_CST); const int hc = h * 64 + tid;
        cst[0 * 64 + tid] = a.in[I_MU][hc]; cst[1 * 64 + tid] = a.in[I_MU][1024 + hc]; cst[2 * 64 + tid] = a.in[I_MU][2048 + hc]; cst[3 * 64 + tid] = a.in[I_MU][3072 + tid]; cst[4 * 64 + tid] = a.in[I_MU][3136 + tid];
        cst[5 * 64 + tid] = a.in[I_W0][hc]; cst[6 * 64 + tid] = a.in[I_A0][hc]; cst[7 * 64 + tid] = a.in[I_KK][hc]; cst[8 * 64 + tid] = a.in[I_KA][hc]; cst[9 * 64 + tid] = a.in[I_RK][hc];
        cst[10 * 64 + tid] = a.in[I_LNG][hc]; cst[11 * 64 + tid] = a.in[I_LNB][hc]; }
#define CSTV(name, idx) float name[8]; { const f32x4 _c0 = *(LAS f32x4*)(lds + RC_CST + (idx) * 256 + c8 * 4), _c1 = *(LAS f32x4*)(lds + RC_CST + (idx) * 256 + c8 * 4 + 16); \
        name[0] = _c0[0]; name[1] = _c0[1]; name[2] = _c0[2]; name[3] = _c0[3]; name[4] = _c1[0]; name[5] = _c1[1]; name[6] = _c1[2]; name[7] = _c1[3]; }
    const int wq = w & 3, rb = wq >> 1, cb = wq & 1;
    __syncthreads();
#define RA_FETCH_Z(p_, rc_, kc_, vc_, rp_, kq_, vp_) do { const int b_ = (p_) >> 6, ck_ = (p_) & 63, tp_ = ck_ * 64 + pt; const size_t tk_ = (size_t)b_ * T + tp_; \
        const bf16* zr_ = zrkv + tk_ * 3072 + ch; rc_ = *(const u32x4*)(zr_); kc_ = *(const u32x4*)(zr_ + 1024); vc_ = *(const u32x4*)(zr_ + 2048); \
        rp_ = (u32x4){0u, 0u, 0u, 0u}; kq_ = rp_; vp_ = rp_; \
        if (tp_ > 0) { rp_ = *(const u32x4*)(zr_ - 3072); kq_ = *(const u32x4*)(zr_ - 3072 + 1024); vp_ = *(const u32x4*)(zr_ - 3072 + 2048); } } while (0)
#define RA_FETCH_W(p_, wdc0_, wdc1_, adc0_, adc1_, wdp0_, wdp1_, adp0_, adp1_) do { const int b_ = (p_) >> 6, ck_ = (p_) & 63, tp_ = ck_ * 64 + pt; const size_t tk_ = (size_t)b_ * T + tp_; \
        wdp0_ = (f32x4){0.f, 0.f, 0.f, 0.f}; wdp1_ = wdp0_; adp0_ = wdp0_; adp1_ = wdp0_; \
        const float* zs_ = zsm + tk_ * 1024; wdc0_ = *(const f32x4*)(zs_ + ZS_WD + c8); wdc1_ = *(const f32x4*)(zs_ + ZS_WD + c8 + 4); adc0_ = *(const f32x4*)(zs_ + ZS_AD + c8); adc1_ = *(const f32x4*)(zs_ + ZS_AD + c8 + 4); \
        if (tp_ > 0) { wdp0_ = *(const f32x4*)(zs_ - 1024 + ZS_WD + c8); wdp1_ = *(const f32x4*)(zs_ - 1024 + ZS_WD + c8 + 4); adp0_ = *(const f32x4*)(zs_ - 1024 + ZS_AD + c8); adp1_ = *(const f32x4*)(zs_ - 1024 + ZS_AD + c8 + 4); } } while (0)
    u32x4 rc, kc, vc, rp, kq, vp;
    if (p0 < 128) RA_FETCH_Z(p0, rc, kc, vc, rp, kq, vp);
    for (int pr = p0; pr < 128; pr += pstep) {
        const int b = pr >> 6, ck = pr & 63; const size_t unit = ((size_t)(b * 16 + h)) * 64 + ck;
        float rs[8], kk[8], kp[8], vs[8], lwv[8], av[8], bc;
        {
            f32x4 wdc0, wdc1, adc0, adc1, wdp0, wdp1, adp0, adp1;
            RA_FETCH_W(pr, wdc0, wdc1, adc0, adc1, wdp0, wdp1, adp0, adp1);
            float wds[8], ads[8];
            CSTV(mu_r, 0) CSTV(mu_k, 1) CSTV(mu_v, 2) CSTV(mu_wd, 3) CSTV(mu_ad, 4)
#pragma unroll
            for (int j = 0; j < 4; ++j) {
                const unsigned rw = j == 0 ? rc.x : j == 1 ? rc.y : j == 2 ? rc.z : rc.w, rpw = j == 0 ? rp.x : j == 1 ? rp.y : j == 2 ? rp.z : rp.w;
                const unsigned kw = j == 0 ? kc.x : j == 1 ? kc.y : j == 2 ? kc.z : kc.w, kpw = j == 0 ? kq.x : j == 1 ? kq.y : j == 2 ? kq.z : kq.w;
                const unsigned vw = j == 0 ? vc.x : j == 1 ? vc.y : j == 2 ? vc.z : vc.w, vpw = j == 0 ? vp.x : j == 1 ? vp.y : j == 2 ? vp.z : vp.w;
                rs[2 * j] = bflo(rw) + mu_r[2 * j] * (bflo(rpw) - bflo(rw)); rs[2 * j + 1] = bfhi(rw) + mu_r[2 * j + 1] * (bfhi(rpw) - bfhi(rw));
                kk[2 * j] = bflo(kw) + mu_k[2 * j] * (bflo(kpw) - bflo(kw)); kk[2 * j + 1] = bfhi(kw) + mu_k[2 * j + 1] * (bfhi(kpw) - bfhi(kw));
                vs[2 * j] = bflo(vw) + mu_v[2 * j] * (bflo(vpw) - bflo(vw)); vs[2 * j + 1] = bfhi(vw) + mu_v[2 * j + 1] * (bfhi(vpw) - bfhi(vw));
                wds[j] = wdc0[j] + mu_wd[j] * (wdp0[j] - wdc0[j]); wds[4 + j] = wdc1[j] + mu_wd[4 + j] * (wdp1[j] - wdc1[j]);
                ads[j] = adc0[j] + mu_ad[j] * (adp0[j] - adc0[j]); ads[4 + j] = adc1[j] + mu_ad[4 + j] * (adp1[j] - adc1[j]); }
            u32x4 pw, pa; pw.x = pk2(tanh_fast(wds[0]), tanh_fast(wds[1])); pw.y = pk2(tanh_fast(wds[2]), tanh_fast(wds[3])); pw.z = pk2(tanh_fast(wds[4]), tanh_fast(wds[5])); pw.w = pk2(tanh_fast(wds[6]), tanh_fast(wds[7]));
            pa.x = pk2(ads[0], ads[1]); pa.y = pk2(ads[2], ads[3]); pa.z = pk2(ads[4], ads[5]); pa.w = pk2(ads[6], ads[7]);
            *(LAS u32x4*)(lds + RC_WDT + pt * MP + c8 * 2) = pw; *(LAS u32x4*)(lds + RC_ADT + pt * MP + c8 * 2) = pa;
        }
        LDS_BARRIER();
        {
            f32x16 acc = zero16();
            if (w < 4) { mm_acc<false, true>(acc, lds + RC_WDT, lds + RC_WUP, rb, cb, lane); st_tile_f32(lds + RC_WPRE, acc, rb, cb, lane); }
            else       { mm_acc<false, true>(acc, lds + RC_ADT, lds + RC_AUP, rb, cb, lane); st_tile_f32(lds + RC_APRE, acc, rb, cb, lane); }
        }
        LDS_BARRIER();
        {
            const f32x4 wp0 = *(LAS f32x4*)(lds + RC_WPRE + pt * FP + c8 * 4), wp1 = *(LAS f32x4*)(lds + RC_WPRE + pt * FP + c8 * 4 + 16);
            const f32x4 ap0 = *(LAS f32x4*)(lds + RC_APRE + pt * FP + c8 * 4), ap1 = *(LAS f32x4*)(lds + RC_APRE + pt * FP + c8 * 4 + 16);
            float n2 = 0.f; bc = 0.f; float ksv[8];
            CSTV(w0, 5) CSTV(a0, 6) CSTV(k_k, 7) CSTV(k_a, 8) CSTV(r_k, 9)
#pragma unroll
            for (int j = 0; j < 8; ++j) { const float wp = w0[j] + (j < 4 ? wp0[j & 3] : wp1[j & 3]), ap = a0[j] + (j < 4 ? ap0[j & 3] : ap1[j & 3]);
                lwv[j] = -__expf(-softplus_f(-wp) - 0.5f); av[j] = __builtin_amdgcn_rcpf(1.0f + __expf(-ap));
                ksv[j] = kk[j]; kk[j] = ksv[j] * k_k[j]; n2 += kk[j] * kk[j]; }
            n2 = allsum8(n2); const float inv = 1.0f / fmaxf(sqrtf(n2), 1e-12f);
#pragma unroll
            for (int j = 0; j < 8; ++j) { kk[j] *= inv; kp[j] = ksv[j] * (1.0f + (av[j] - 1.0f) * k_a[j]); bc += rs[j] * kp[j] * r_k[j]; }
            bc = allsum8(bc);
            if ((tid & 7) == 0) ((float*)(ws + WS_RBC))[unit * 64 + pt] = bc;
            *(LAS f32x4*)(lds + RC_LW + pt * FP + c8 * 4) = (f32x4){lwv[0], lwv[1], lwv[2], lwv[3]}; *(LAS f32x4*)(lds + RC_LW + pt * FP + c8 * 4 + 16) = (f32x4){lwv[4], lwv[5], lwv[6], lwv[7]};
        }
        LDS_BARRIER();
        {
            const int kc = tid & 63, g = tid >> 6; float run = 0.f;
#pragma unroll
            for (int j = 0; j < 8; ++j) { LAS float* pp = (LAS float*)(lds + RC_LW + (8 * g + j) * FP + kc * 4); run += *pp; *pp = run; }
            *(LAS float*)(lds + RC_TOT + g * 256 + kc * 4) = run;
        }
        LDS_BARRIER();
        {   const int kc = tid & 63, g = tid >> 6; float off = 0.f;
            for (int gg = 0; gg < g; ++gg) off += *(LAS float*)(lds + RC_TOT + gg * 256 + kc * 4);
#pragma unroll
            for (int j = 0; j < 8; ++j) { LAS float* pp = (LAS float*)(lds + RC_LW + (8 * g + j) * FP + kc * 4); *pp += off; }
        }
        LDS_BARRIER();
        {
            const f32x4 c0 = *(LAS f32x4*)(lds + RC_LW + pt * FP + c8 * 4), c1 = *(LAS f32x4*)(lds + RC_LW + pt * FP + c8 * 4 + 16);
            const f32x4 m0 = *(LAS f32x4*)(lds + RC_LW + 31 * FP + c8 * 4), m1 = *(LAS f32x4*)(lds + RC_LW + 31 * FP + c8 * 4 + 16);
            float at[8], rt[8], bt[8], kt[8];
#pragma unroll
            for (int j = 0; j < 8; ++j) { const float cin = j < 4 ? c0[j & 3] : c1[j & 3], mm = j < 4 ? m0[j & 3] : m1[j & 3];
                const float er = __expf(cin - mm), ea = er * __expf(-lwv[j]), eb = __builtin_amdgcn_rcpf(er);
                at[j] = -kk[j] * ea; rt[j] = rs[j] * er; bt[j] = kk[j] * av[j] * eb; kt[j] = kp[j] * eb; }
            u32x4 pw;
            pw.x = pk2(at[0], at[1]); pw.y = pk2(at[2], at[3]); pw.z = pk2(at[4], at[5]); pw.w = pk2(at[6], at[7]); *(LAS u32x4*)(lds + RC_AT + pt * MP + c8 * 2) = pw;
            pw.x = pk2(rt[0], rt[1]); pw.y = pk2(rt[2], rt[3]); pw.z = pk2(rt[4], rt[5]); pw.w = pk2(rt[6], rt[7]); *(LAS u32x4*)(lds + RC_RT + pt * MP + c8 * 2) = pw;
            pw.x = pk2(bt[0], bt[1]); pw.y = pk2(bt[2], bt[3]); pw.z = pk2(bt[4], bt[5]); pw.w = pk2(bt[6], bt[7]); *(LAS u32x4*)(lds + RC_BT + pt * MP + c8 * 2) = pw;
            pw.x = pk2(kt[0], kt[1]); pw.y = pk2(kt[2], kt[3]); pw.z = pk2(kt[4], kt[5]); pw.w = pk2(kt[6], kt[7]); *(LAS u32x4*)(lds + RC_KT + pt * MP + c8 * 2) = pw;
            pw.x = pk2(vs[0], vs[1]); pw.y = pk2(vs[2], vs[3]); pw.z = pk2(vs[4], vs[5]); pw.w = pk2(vs[6], vs[7]); *(LAS u32x4*)(lds + RC_VT + pt * MP + c8 * 2) = pw;
            if (pt == 0) { const f32x4 l0 = *(LAS f32x4*)(lds + RC_LW + 63 * FP + c8 * 4), l1 = *(LAS f32x4*)(lds + RC_LW + 63 * FP + c8 * 4 + 16);
#pragma unroll
                for (int j = 0; j < 8; ++j) { const float mm = j < 4 ? m0[j & 3] : m1[j & 3], cl = j < 4 ? l0[j & 3] : l1[j & 3];
                    *(LAS float*)(lds + RC_VEC + (c8 + j) * 4) = __expf(mm); *(LAS float*)(lds + RC_VEC + 256 + (c8 + j) * 4) = __expf(cl); *(LAS float*)(lds + RC_VEC + 512 + (c8 + j) * 4) = __expf(cl - mm); } }
        }
        LDS_BARRIER();
        if (pr + pstep < 128) RA_FETCH_Z(pr + pstep, rc, kc, vc, rp, kq, vp);
        f32x16 macc = zero16();
        if (w < 4) { f32x16 acc = zero16(); mm_acc<false, false>(acc, lds + RC_AT, lds + RC_BT, rb, cb, lane); mask_tril<false>(acc, rb, cb, lane);
            st_tile_bf16(lds + RC_XA, acc, rb, cb, lane);
            const int row = 32 * rb + (lane & 31);
#pragma unroll
            for (int j = 0; j < 16; ++j) { const int col = 32 * cb + (j & 3) + 8 * (j >> 2) + 4 * (lane >> 5); macc[j] = acc[j] + (col == row ? 1.0f : 0.0f); }
            st_tile_bf16(lds + RC_TA, macc, rb, cb, lane);
        } else { f32x16 acc = zero16(); mm_acc<false, false>(acc, lds + RC_AT, lds + RC_KT, rb, cb, lane); mask_tril<false>(acc, rb, cb, lane); st_tile_bf16(lds + RC_MAK, acc, rb, cb, lane); }
        LDS_BARRIER();
        if (w < 4) { f32x16 acc = zero16(); mm_acc<false, true>(acc, lds + RC_XA, lds + RC_XA, rb, cb, lane); st_tile_bf16(lds + RC_XB, acc, rb, cb, lane); }
        else { f32x16 acc = zero16(); mm_acc<false, false>(acc, lds + RC_RT, lds + RC_BT, rb, cb, lane); mask_tril<true>(acc, rb, cb, lane); st_tile_bf16(lds + RC_NRB, acc, rb, cb, lane); }
        LDS_BARRIER();
        if (w < 4) { mm_acc<false, true>(macc, lds + RC_TA, lds + RC_XB, rb, cb, lane); st_tile_bf16(lds + RC_TB, macc, rb, cb, lane); }
        else { f32x16 acc = zero16(); mm_acc<false, true>(acc, lds + RC_XB, lds + RC_XB, rb, cb, lane); st_tile_bf16(lds + RC_XA, acc, rb, cb, lane); }
        LDS_BARRIER();
        if (w < 4) { mm_acc<false, true>(macc, lds + RC_TB, lds + RC_XA, rb, cb, lane); st_tile_bf16(lds + RC_TA, macc, rb, cb, lane); }
        else { f32x16 acc = zero16(); mm_acc<false, true>(acc, lds + RC_XA, lds + RC_XA, rb, cb, lane); st_tile_bf16(lds + RC_XB, acc, rb, cb, lane); }
        LDS_BARRIER();
        if (w < 4) { mm_acc<false, true>(macc, lds + RC_TA, lds + RC_XB, rb, cb, lane); st_tile_bf16(lds + RC_TB, macc, rb, cb, lane); }
        else { f32x16 acc = zero16(); mm_acc<false, true>(acc, lds + RC_XB, lds + RC_XB, rb, cb, lane); st_tile_bf16(lds + RC_XA, acc, rb, cb, lane); }
        LDS_BARRIER();
        if (w < 4) { mm_acc<false, true>(macc, lds + RC_TB, lds + RC_XA, rb, cb, lane); st_tile_bf16(lds + RC_TA, macc, rb, cb, lane); }
        else { f32x16 acc = zero16(); mm_acc<false, true>(acc, lds + RC_XA, lds + RC_XA, rb, cb, lane); st_tile_bf16(lds + RC_XB, acc, rb, cb, lane); }
        LDS_BARRIER();
        if (w < 4) { mm_acc<false, true>(macc, lds + RC_TA, lds + RC_XB, rb, cb, lane); st_tile_bf16(lds + RC_TB, macc, rb, cb, lane); }
        else { f32x16 acc = zero16(); mm_acc<false, false>(acc, lds + RC_RT, lds + RC_KT, rb, cb, lane); mask_tril<true>(acc, rb, cb, lane); st_tile_bf16(lds + RC_NRK, acc, rb, cb, lane);
            acc = zero16(); mm_acc<false, true>(acc, lds + RC_MAK, lds + RC_VT, rb, cb, lane); st_tile_bf16(lds + RC_XA, acc, rb, cb, lane); }
        LDS_BARRIER();
        if (w < 4) { f32x16 acc = zero16(); mm_acc<false, true>(acc, lds + RC_TB, lds + RC_AT, rb, cb, lane);
#pragma unroll
            for (int j = 0; j < 16; ++j) acc[j] *= *(LAS float*)(lds + RC_VEC + (32 * cb + (j & 3) + 8 * (j >> 2) + 4 * (lane >> 5)) * 4);
            st_tile_bf16(lds + RC_XB, acc, rb, cb, lane); }
        else { f32x16 acc = zero16(); mm_acc<false, true>(acc, lds + RC_TB, lds + RC_XA, rb, cb, lane); st_tile_bf16(lds + RC_TA, acc, rb, cb, lane); }
        LDS_BARRIER();
        if (w < 4) { f32x16 acc = zero16(); mm_acc<false, true>(acc, lds + RC_NRB, lds + RC_XB, rb, cb, lane);
            { LAS const unsigned char* rrow = lds + RC_RT + (32 * rb + (lane & 31)) * MP + (32 * cb + 4 * (lane >> 5)) * 2;
#pragma unroll
              for (int g = 0; g < 4; ++g) { const u32x2 rw = *(LAS const u32x2*)(rrow + 16 * g); const f32x4 em = *(LAS f32x4*)(lds + RC_VEC + (32 * cb + 4 * (lane >> 5) + 8 * g) * 4);
                  acc[4 * g] += bflo(rw.x) * em[0]; acc[4 * g + 1] += bfhi(rw.x) * em[1]; acc[4 * g + 2] += bflo(rw.y) * em[2]; acc[4 * g + 3] += bfhi(rw.y) * em[3]; } }
            st_tile_bf16(lds + RC_XA, acc, rb, cb, lane);
            acc = zero16(); mm_acc<false, true>(acc, lds + RC_NRB, lds + RC_TA, rb, cb, lane); mm_acc<false, true>(acc, lds + RC_NRK, lds + RC_VT, rb, cb, lane);
            st_tile_bf16(lds + RC_TB, acc, rb, cb, lane); }
        else { const int krow = 32 * rb + (lane & 31);
            const float ecl = *(LAS float*)(lds + RC_VEC + 256 + krow * 4), eclm = *(LAS float*)(lds + RC_VEC + 512 + krow * 4);
            f32x16 acc = zero16(); mm_acc<true, true>(acc, lds + RC_BT, lds + RC_XB, rb, cb, lane);
#pragma unroll
            for (int j = 0; j < 16; ++j) { const int col = 32 * cb + (j & 3) + 8 * (j >> 2) + 4 * (lane >> 5); acc[j] = eclm * acc[j] + (col == krow ? ecl : 0.0f); }
            st_tile_bf16(lds + RC_MAK, acc, rb, cb, lane);
            acc = zero16(); mm_acc<true, true>(acc, lds + RC_BT, lds + RC_TA, rb, cb, lane); mm_acc<true, true>(acc, lds + RC_KT, lds + RC_VT, rb, cb, lane);
#pragma unroll
            for (int j = 0; j < 16; ++j) acc[j] *= eclm;
            st_tile_bf16(lds + RC_S0, acc, rb, cb, lane); }
        LDS_BARRIER();
        {
            const u32x4 o0 = *(LAS u32x4*)(lds + RC_XA + pt * MP + c8 * 2), o1 = *(LAS u32x4*)(lds + RC_TB + pt * MP + c8 * 2), o2 = *(LAS u32x4*)(lds + RC_MAK + pt * MP + c8 * 2), o3 = *(LAS u32x4*)(lds + RC_S0 + pt * MP + c8 * 2);
            *(u32x4*)((bf16*)(ws + WS_RWR) + unit * 4096 + pt * 64 + c8) = o0;
            *(u32x4*)((bf16*)(ws + WS_ZSM + ((size_t)b * T + (size_t)ck * 64 + pt) * 4096 + YLOC_OFF(h)) + c8) = o1;
            *(u32x4*)((bf16*)(ws + WS_RG) + unit * 4096 + pt * 64 + c8) = o2;
            *(u32x4*)((bf16*)(ws + WS_RSL) + unit * 4096 + pt * 64 + c8) = o3; }
        LDS_BARRIER();
    }
#undef RA_FETCH_Z
#undef RA_FETCH_W
}

constexpr int RB_GM = 0, RB_WR = 9216, RB_SB = 18432, RB_YF = 27648, RB_YL = 45056, RB_SL = 54272;
__device__ __forceinline__ void rwkvB_unit(const Args& a, LAS unsigned char* lds, int b, int h) {
    const int tid = threadIdx.x, lane = tid & 63, w = __builtin_amdgcn_readfirstlane(tid >> 6);
    unsigned char* ws = a.ws;
    const bf16* zrkv = (const bf16*)(ws + WS_ZRKV); const bf16* gates = (const bf16*)(ws + WS_GATES); bf16* mixed = (bf16*)(ws + WS_XN);
    const bf16* Gg = (const bf16*)(ws + WS_RG); const bf16* SLg = (const bf16*)(ws + WS_RSL); const bf16* WRg = (const bf16*)(ws + WS_RWR); const float* BCg = (const float*)(ws + WS_RBC);
    const int pt = tid >> 3, c8 = (tid & 7) * 8, ch = h * 64 + c8;
    if (tid < 64) { LAS float* cst = (LAS float*)(lds + RC_CST); const int hc = h * 64 + tid; cst[2 * 64 + tid] = a.in[I_MU][2048 + hc]; cst[10 * 64 + tid] = a.in[I_LNG][hc]; cst[11 * 64 + tid] = a.in[I_LNB][hc]; }
    const int wq = w & 3, rb = wq >> 1, cb = wq & 1;
    const size_t u0 = ((size_t)(b * 16 + h)) * 64;
    { const f32x16 z = zero16(); if (w >= 4) st_tile_bf16(lds + RB_SB, z, rb, cb, lane); }
#define RB_FETCH(ck_, gp_, wp_, yl_, sl_, vc_, vp_, g4_, bc_) do { const size_t un_ = u0 + (ck_); const int tp_ = (ck_) * 64 + pt; const size_t tk_ = (size_t)b * T + tp_; \
        gp_ = *(const u32x4*)(Gg + un_ * 4096 + pt * 64 + c8); wp_ = *(const u32x4*)(WRg + un_ * 4096 + pt * 64 + c8); \
        yl_ = *(const u32x4*)((const bf16*)(ws + WS_ZSM + ((size_t)b * T + (size_t)tp_) * 4096 + YLOC_OFF(h)) + c8); sl_ = *(const u32x4*)(SLg + un_ * 4096 + pt * 64 + c8); \
        const bf16* zr_ = zrkv + tk_ * 3072 + 2048 + ch; vc_ = *(const u32x4*)(zr_); vp_ = (u32x4){0u, 0u, 0u, 0u}; if (tp_ > 0) vp_ = *(const u32x4*)(zr_ - 3072); \
        g4_ = *(const u32x4*)(gates + tk_ * 2048 + ch); bc_ = BCg[un_ * 64 + pt]; } while (0)
    u32x4 gp, wp, yl, sl, vc, vp, g4; float bc;
    RB_FETCH(0, gp, wp, yl, sl, vc, vp, g4, bc);
    for (int ck = 0; ck < T / 64; ++ck) {
        const int tpos = ck * 64 + pt; const size_t tok = (size_t)b * T + tpos;
        *(LAS u32x4*)(lds + RB_GM + pt * MP + c8 * 2) = gp; *(LAS u32x4*)(lds + RB_WR + pt * MP + c8 * 2) = wp; *(LAS u32x4*)(lds + RB_YL + pt * MP + c8 * 2) = yl; *(LAS u32x4*)(lds + RB_SL + pt * MP + c8 * 2) = sl;
        u32x4 gpn = gp, wpn = wp, yln = yl, sln = sl, vcn = vc, vpn = vp, g4n = g4; float bcn = bc;
        if (ck + 1 < T / 64) RB_FETCH(ck + 1, gpn, wpn, yln, sln, vcn, vpn, g4n, bcn);
        LDS_BARRIER();
        f32x16 loc;
        {
            LAS const unsigned char* rowp = lds + (w < 4 ? RB_YL : RB_SL) + (32 * rb + (lane & 31)) * MP + (32 * cb + 4 * (lane >> 5)) * 2;
#pragma unroll
            for (int g = 0; g < 4; ++g) { const u32x2 wv = *(LAS const u32x2*)(rowp + 16 * g); loc[4 * g] = bflo(wv.x); loc[4 * g + 1] = bfhi(wv.x); loc[4 * g + 2] = bflo(wv.y); loc[4 * g + 3] = bfhi(wv.y); } }
        if (w < 4) { mm_acc<false, true>(loc, lds + RB_WR, lds + RB_SB, rb, cb, lane); st_tile_f32(lds + RB_YF, loc, rb, cb, lane); }
        else { mm_acc<false, true>(loc, lds + RB_GM, lds + RB_SB, rb, cb, lane); }
        LDS_BARRIER();
        if (w >= 4) st_tile_bf16(lds + RB_SB, loc, rb, cb, lane);
        {
            const f32x4 y0 = *(LAS f32x4*)(lds + RB_YF + pt * FP + c8 * 4), y1 = *(LAS f32x4*)(lds + RB_YF + pt * FP + c8 * 4 + 16);
            float yv[8];
#pragma unroll
            for (int j = 0; j < 8; ++j) yv[j] = j < 4 ? y0[j & 3] : y1[j & 3];
            float sm = 0.f;
#pragma unroll
            for (int j = 0; j < 8; ++j) sm += yv[j];
            const float mean = allsum8(sm) * (1.0f / 64.0f); float sq = 0.f;
#pragma unroll
            for (int j = 0; j < 8; ++j) { yv[j] -= mean; sq += yv[j] * yv[j]; }
            const float rstd = rsqrtf(allsum8(sq) * (1.0f / 64.0f) + 64e-5f);
            float o[8];
            CSTV(mu_v, 2) CSTV(ln_g, 10) CSTV(ln_b, 11)
#pragma unroll
            for (int j = 0; j < 4; ++j) { const unsigned gw = j == 0 ? g4.x : j == 1 ? g4.y : j == 2 ? g4.z : g4.w;
                const unsigned vw = j == 0 ? vc.x : j == 1 ? vc.y : j == 2 ? vc.z : vc.w, vpw = j == 0 ? vp.x : j == 1 ? vp.y : j == 2 ? vp.z : vp.w;
                const float v0 = bflo(vw) + mu_v[2 * j] * (bflo(vpw) - bflo(vw)), v1 = bfhi(vw) + mu_v[2 * j + 1] * (bfhi(vpw) - bfhi(vw));
                o[2 * j] = (yv[2 * j] * rstd * ln_g[2 * j] + ln_b[2 * j] + bc * v0) * bflo(gw);
                o[2 * j + 1] = (yv[2 * j + 1] * rstd * ln_g[2 * j + 1] + ln_b[2 * j + 1] + bc * v1) * bfhi(gw); }
            u32x4 ow; ow.x = pk2(o[0], o[1]); ow.y = pk2(o[2], o[3]); ow.z = pk2(o[4], o[5]); ow.w = pk2(o[6], o[7]);
            *(u32x4*)(mixed + tok * 2048 + ch) = ow;
        }
        LDS_BARRIER();
        gp = gpn; wp = wpn; yl = yln; sl = sln; vc = vcn; vp = vpn; g4 = g4n; bc = bcn;
    }
#undef RB_FETCH
}

constexpr int CS_PITCH = 560, PB_PITCH = 80;
constexpr int DSA_WSLAB = 32 * CS_PITCH + 16 * PB_PITCH + 64;
__device__ __forceinline__ unsigned fkey(float x) { const unsigned u = __builtin_bit_cast(unsigned, x); return (u & 0x80000000u) ? ~u : (u | 0x80000000u); }
__device__ __forceinline__ int mbcnt64(unsigned long long m) { return __builtin_amdgcn_mbcnt_hi((unsigned)(m >> 32), __builtin_amdgcn_mbcnt_lo((unsigned)m, 0u)); }
__device__ __forceinline__ int t5_bucket(int rel) {
    const int n = rel < 0 ? -rel : rel; int r = rel > 0 ? 16 : 0;
    if (n < 8) return r + n;
    int large = 2 + (31 - __clz(n * n)); if (large > 15) large = 15;
    return r + large;
}
__device__ __forceinline__ void dsa_scores4(const Args& a, LAS float* SC, LAS const unsigned char* QI, LAS const float* WI, int b, int q0, int L, int xw, int lane) {
    unsigned char* ws = a.ws;
    const bf16* qidx = (const bf16*)(ws + WS_QIDX); const bf16* kidx = (const bf16*)(ws + WS_KIDX); const float* widx = (const float*)(ws + WS_WIDX);
    const size_t tok0 = (size_t)b * T + q0, kb = (size_t)b * T;
    if (L > 256) {
        const int i = lane & 31, half = lane >> 5, head = (i & 3) | ((i >> 3) << 2), qsub = (i >> 2) & 1;
        bf16x8 af[2][4]; float wq[2][16];
#pragma unroll
        for (int rbk = 0; rbk < 2; ++rbk) {
#pragma unroll
            for (int ks = 0; ks < 4; ++ks) af[rbk][ks] = *(LAS const bf16x8*)(QI + (rbk * 32 + i) * 144 + ks * 32 + half * 16);
#pragma unroll
            for (int j = 0; j < 4; ++j) { const f32x4 v = *(LAS const f32x4*)(WI + (2 * rbk + half) * 16 + j * 4); wq[rbk][j * 4 + 0] = v[0]; wq[rbk][j * 4 + 1] = v[1]; wq[rbk][j * 4 + 2] = v[2]; wq[rbk][j * 4 + 3] = v[3]; }
        }
        const int ntiles = L / 32; const bf16* kp0 = kidx + (kb >> 5) * 2048 + lane * 8;
        bf16x8 B[4][4];
#pragma unroll
        for (int j = 0; j < 4; ++j) { const int t0 = (xw + 4 * j < ntiles) ? xw + 4 * j : xw;
#pragma unroll
            for (int ks = 0; ks < 4; ++ks) B[j][ks] = *(const bf16x8*)(kp0 + (size_t)t0 * 2048 + ks * 512); }
#define DSA_MM(acc_, rbk_, j_) do { _Pragma("unroll") for (int jj = 0; jj < 16; ++jj) acc_[jj] = 0.f; \
                _Pragma("unroll") for (int ks = 0; ks < 4; ++ks) acc_ = __builtin_amdgcn_mfma_f32_32x32x16_bf16(af[rbk_][ks], B[j_][ks], acc_, 0, 0, 0); } while (0)
#define DSA_EPI(acc_, rbk_) do { f32x2_t sc2_ = {0.f, 0.f}; \
                _Pragma("unroll") for (int jj = 0; jj < 16; jj += 2) { int x0_ = __float_as_int(acc_[jj]), x1_ = __float_as_int(acc_[jj + 1]); x0_ = x0_ > 0 ? x0_ : 0; x1_ = x1_ > 0 ? x1_ : 0; \
                    const f32x2_t r2_ = {__int_as_float(x0_), __int_as_float(x1_)}; const f32x2_t w2_ = {wq[rbk_][jj], wq[rbk_][jj + 1]}; sc2_ = __builtin_elementwise_fma(w2_, r2_, sc2_); } \
                SC[(2 * (rbk_) + half) * 4096 + kt * 32 + i] = sc2_.x + sc2_.y; } while (0)
        int kt0 = xw;
        for (; kt0 + 12 < ntiles; kt0 += 16) {
#pragma unroll
            for (int j = 0; j < 4; ++j) { const int kt = kt0 + 4 * j; f32x16 accA, accB;
                DSA_MM(accA, 0, j); DSA_MM(accB, 1, j);
                { float a0_ = accA[0], b0_ = accB[0]; asm volatile("" : "+v"(a0_), "+v"(b0_)); accA[0] = a0_; accB[0] = b0_; }
                { const int tn = (kt + 16 < ntiles) ? kt + 16 : kt;
#pragma unroll
                  for (int ks = 0; ks < 4; ++ks) B[j][ks] = *(const bf16x8*)(kp0 + (size_t)tn * 2048 + ks * 512); }
                DSA_EPI(accA, 0); DSA_EPI(accB, 1); }
        }
#pragma unroll
        for (int j = 0; j < 4; ++j) { const int kt = kt0 + 4 * j;
            if (kt < ntiles) { f32x16 accA, accB;
                DSA_MM(accA, 0, j); DSA_MM(accB, 1, j);
                { float a0_ = accA[0], b0_ = accB[0]; asm volatile("" : "+v"(a0_), "+v"(b0_)); accA[0] = a0_; accB[0] = b0_; }
                DSA_EPI(accA, 0); DSA_EPI(accB, 1); } }
#undef DSA_MM
#undef DSA_EPI
    }
}

template <class F> __device__ __forceinline__ void dsa_select(LAS const float* SCrow, LAS unsigned short* SELr, int L, int lane, F after_load) {
    if (L <= 256) {
        after_load();
        for (int j = lane; j < 256; j += 64) SELr[j] = (unsigned short)j;
    } else {
        const int nreg = L / 64; unsigned u[64];
        {
            float xs[64];
#pragma unroll
            for (int g = 0; g < 4; ++g) if (g * 16 < nreg) {
#pragma unroll
                for (int j = 16 * g; j < 16 * g + 16; ++j) xs[j] = SCrow[j * 64 + lane]; }
#pragma unroll
            for (int g = 0; g < 4; ++g) {
                if (g * 16 < nreg) {
#pragma unroll
                    for (int j = 16 * g; j < 16 * g + 16; ++j) u[j] = (j < nreg) ? fkey(xs[j]) : 0u;
                } else {
#pragma unroll
                    for (int j = 16 * g; j < 16 * g + 16; ++j) u[j] = 0u; } }
        }
        after_load();
#define DSA_CNT4(acc_, c_, k0_) do { unsigned long long m0_, m1_, m2_, m3_; \
            asm volatile("v_cmp_le_u32_e64 %1, %5, %6\n\tv_cmp_le_u32_e64 %2, %5, %7\n\tv_cmp_le_u32_e64 %3, %5, %8\n\tv_cmp_le_u32_e64 %4, %5, %9\n\t" \
                         "v_addc_co_u32_e64 %0, %1, 0, %0, %1\n\tv_addc_co_u32_e64 %0, %2, 0, %0, %2\n\tv_addc_co_u32_e64 %0, %3, 0, %0, %3\n\tv_addc_co_u32_e64 %0, %4, 0, %0, %4" \
                         : "+v"(acc_), "=&s"(m0_), "=&s"(m1_), "=&s"(m2_), "=&s"(m3_) : "s"(c_), "v"(u[(k0_)]), "v"(u[(k0_) + 1]), "v"(u[(k0_) + 2]), "v"(u[(k0_) + 3])); } while (0)
#define DSA_COUNT(NG_, c_, cnt_) do { int c0_ = 0, c1_ = 0; const unsigned cc_ = __builtin_amdgcn_readfirstlane(c_); \
            _Pragma("unroll") for (int g8 = 0; g8 < (NG_); ++g8) { DSA_CNT4(c0_, cc_, g8 * 8); DSA_CNT4(c1_, cc_, g8 * 8 + 4); } \
            int cl_ = c0_ + c1_; \
            cl_ += __builtin_amdgcn_update_dpp(0, cl_, 0xB1, 0xF, 0xF, true); cl_ += __builtin_amdgcn_update_dpp(0, cl_, 0x4E, 0xF, 0xF, true); \
            cl_ += __builtin_amdgcn_update_dpp(0, cl_, 0x141, 0xF, 0xF, true); cl_ += __builtin_amdgcn_update_dpp(0, cl_, 0x140, 0xF, 0xF, true); \
            cnt_ = __builtin_amdgcn_readlane(cl_, 0) + __builtin_amdgcn_readlane(cl_, 16) + __builtin_amdgcn_readlane(cl_, 32) + __builtin_amdgcn_readlane(cl_, 48); } while (0)
        unsigned umax = 0u;
#pragma unroll
        for (int g8 = 0; g8 < 8; ++g8) if (g8 * 8 < nreg) {
#pragma unroll
            for (int j = 8 * g8; j < 8 * g8 + 8; ++j) umax = umax > u[j] ? umax : u[j]; }
        { int m = (int)umax; m = max(m ^ 0x80000000, __builtin_amdgcn_update_dpp(0, m ^ 0x80000000, 0xB1, 0xF, 0xF, true)); m = max(m, __builtin_amdgcn_update_dpp(0, m, 0x4E, 0xF, 0xF, true));
          m = max(m, __builtin_amdgcn_update_dpp(0, m, 0x141, 0xF, 0xF, true)); m = max(m, __builtin_amdgcn_update_dpp(0, m, 0x140, 0xF, 0xF, true));
          m = max(max(__builtin_amdgcn_readlane(m, 0), __builtin_amdgcn_readlane(m, 16)), max(__builtin_amdgcn_readlane(m, 32), __builtin_amdgcn_readlane(m, 48))); umax = (unsigned)m ^ 0x80000000u; }
        unsigned lo = 1u, hi = umax + 1u, thr = 0u; bool exact = false;
#define DSA_SEARCH(NG_) do { unsigned c = umax & 0xFF800000u; int cnt;          \
            for (int step = 0; step < 6; ++step) { if (c <= 1u) break; DSA_COUNT(NG_, c, cnt); if (cnt == 256) { thr = c; exact = true; break; } if (cnt > 256) { lo = c; break; } hi = c; if (c < 0x00800000u + 1u) break; c -= 0x00800000u; } \
            while (!exact && hi - lo > 1u) { const unsigned mid = lo + ((hi - lo) >> 1); DSA_COUNT(NG_, mid, cnt); if (cnt == 256) { thr = mid; exact = true; } else if (cnt > 256) lo = mid; else hi = mid; } \
            if (!exact) thr = lo;              \
        } while (0)
        switch ((nreg + 7) >> 3) { case 1: DSA_SEARCH(1); break; case 2: DSA_SEARCH(2); break; case 3: DSA_SEARCH(3); break; case 4: DSA_SEARCH(4); break;
                                   case 5: DSA_SEARCH(5); break; case 6: DSA_SEARCH(6); break; case 7: DSA_SEARCH(7); break; default: DSA_SEARCH(8); break; }
#undef DSA_SEARCH
        if (exact) {
            int cl = 0; { int c1 = 0; const unsigned tt = __builtin_amdgcn_readfirstlane(thr);
#pragma unroll
                for (int g8 = 0; g8 < 8; ++g8) if (g8 * 8 < nreg) { DSA_CNT4(cl, tt, g8 * 8); DSA_CNT4(c1, tt, g8 * 8 + 4); }
                cl += c1; }
            int x = cl;
            x += __builtin_amdgcn_update_dpp(0, x, 0x111, 0xF, 0xF, true); x += __builtin_amdgcn_update_dpp(0, x, 0x112, 0xF, 0xF, true);
            x += __builtin_amdgcn_update_dpp(0, x, 0x114, 0xF, 0xF, true); x += __builtin_amdgcn_update_dpp(0, x, 0x118, 0xF, 0xF, true);
            x += __builtin_amdgcn_update_dpp(0, x, 0x142, 0xA, 0xF, false);
            x += __builtin_amdgcn_update_dpp(0, x, 0x143, 0xC, 0xF, false);
            int off = x - cl;
#pragma unroll
            for (int g8 = 0; g8 < 8; ++g8) if (g8 * 8 < nreg) {
#pragma unroll
                for (int j = 8 * g8; j < 8 * g8 + 8; ++j) { if (u[j] >= thr) { SELr[off] = (unsigned short)(j * 64 + lane); ++off; } } }
        } else {
            int ngt = 0;
#pragma unroll
            for (int j = 0; j < 64; ++j) if (j < nreg) ngt += __popcll(__ballot(u[j] > thr));
            int ties_left = 256 - ngt, pos = 0;
#pragma unroll
            for (int j = 0; j < 64; ++j) if (j < nreg) {
                const bool gt = u[j] > thr, eq = u[j] == thr;
                const unsigned long long em = __ballot(eq);
                const bool take = gt || (eq && mbcnt64(em) < ties_left);
                const unsigned long long tm = __ballot(take);
                if (take) SELr[pos + mbcnt64(tm)] = (unsigned short)(j * 64 + lane);
                pos += __popcll(tm); const int ne = __popcll(em); ties_left -= (ne < ties_left ? ne : ties_left);
            }
        }
#undef DSA_COUNT
#undef DSA_CNT4
    }
}

__device__ __forceinline__ void dsa_attend(const Args& a, LAS unsigned char* CSw, LAS const unsigned short* SELr, LAS const float* BIAS, int b, int qpos, int nk, int lane) {
    unsigned char* ws = a.ws; const bf16* ckv = (const bf16*)(ws + WS_CKV); bf16* qabs = (bf16*)a.out;
    {
        const int fr = lane & 15, hq = lane >> 4, g = lane >> 4, qq = (lane & 15) >> 2, pp = lane & 3;
        LAS unsigned char* PBw = CSw + 32 * CS_PITCH; LAS float* MSw = (LAS float*)(PBw + 16 * PB_PITCH);
        const size_t tok = (size_t)b * T + qpos, kb = (size_t)b * T;
        const int nch = nk / 32;
        float rinvq; { const float* qs = (const float*)(ws + WS_QSS) + tok * 8; const f32x4 s0 = *(const f32x4*)qs, s1 = *(const f32x4*)(qs + 4);
            rinvq = rsqrtf(((s0[0] + s0[1]) + (s0[2] + s0[3]) + (s1[0] + s1[1]) + (s1[2] + s1[3])) * (1.0f / 384.0f) + 1e-6f); }
        bf16x8 gl[16], aq[8];
#define DSA_LOAD_CH(c_) do { \
        _Pragma("unroll") for (int i_ = 0; i_ < 16; ++i_) { const int idx = SELr[32 * (c_) + (i_ >> 2) * 8 + (lane >> 3)]; \
            gl[i_] = *(const bf16x8*)(ckv + (kb + idx) * KVR + (i_ & 3) * 64 + (lane & 7) * 8); } } while (0)
#pragma unroll
        for (int ks = 0; ks < 8; ++ks) aq[ks] = __builtin_nontemporal_load((const bf16x8*)(qabs + tok * 4096 + fr * 256 + ks * 32 + hq * 8));
        DSA_LOAD_CH(0);
        f32x4 oacc[16];
#pragma unroll
        for (int nt = 0; nt < 16; ++nt) oacc[nt] = (f32x4){0.f, 0.f, 0.f, 0.f};
        float mref[4] = {0.f, 0.f, 0.f, 0.f}, lsum[4] = {0.f, 0.f, 0.f, 0.f};
        for (int c = 0; c < nch; ++c) {
#pragma unroll
            for (int i_ = 0; i_ < 16; ++i_) *(LAS bf16x8*)(CSw + ((i_ >> 2) * 8 + (lane >> 3)) * CS_PITCH + (i_ & 3) * 128 + (lane & 7) * 16) = gl[i_];
            if (c + 1 < nch) DSA_LOAD_CH(c + 1);
            f32x4 sv[2];
#pragma unroll
            for (int j = 0; j < 2; ++j) { f32x4 acc = (f32x4){0.f, 0.f, 0.f, 0.f};
#pragma unroll
                for (int ks = 0; ks < 8; ++ks) { const bf16x8 bfr = *(LAS bf16x8*)(CSw + (16 * j + fr) * CS_PITCH + (ks * 32 + hq * 8) * 2); acc = __builtin_amdgcn_mfma_f32_16x16x32_bf16(aq[ks], bfr, acc, 0, 0, 0); }
                const int kidxv = SELr[32 * c + 16 * j + fr]; const int bk = t5_bucket(kidxv - qpos);
                sv[j] = acc * rinvq + *(LAS f32x4*)(BIAS + bk * 16 + hq * 4); }
            if (c == 0) {
#pragma unroll
                for (int r = 0; r < 4; ++r) mref[r] = allmax16(fmaxf(sv[0][r], sv[1][r]));
            }
#pragma unroll
            for (int r = 0; r < 4; ++r) { const float p0 = __expf(sv[0][r] - mref[r]), p1 = __expf(sv[1][r] - mref[r]); lsum[r] += p0 + p1;
                *(LAS unsigned short*)(PBw + (hq * 4 + r) * PB_PITCH + fr * 2) = (unsigned short)f2bf(p0);
                *(LAS unsigned short*)(PBw + (hq * 4 + r) * PB_PITCH + (16 + fr) * 2) = (unsigned short)f2bf(p1); }
            asm volatile("s_waitcnt lgkmcnt(0)" ::: "memory");
            const bf16x8 pa = *(LAS bf16x8*)(PBw + fr * PB_PITCH + hq * 16);
            LAS unsigned char* base = CSw + (8 * g + qq) * CS_PITCH + (4 * pp) * 2;
#pragma unroll
            for (int nt = 0; nt < 16; ++nt) {
                const s16x4 b0 = __builtin_amdgcn_ds_read_tr16_b64_v4i16((LAS s16x4*)(base + nt * 32));
                const s16x4 b1 = __builtin_amdgcn_ds_read_tr16_b64_v4i16((LAS s16x4*)(base + nt * 32 + 4 * CS_PITCH));
                const bf16x8 bf = (bf16x8){b0[0], b0[1], b0[2], b0[3], b1[0], b1[1], b1[2], b1[3]};
                oacc[nt] = __builtin_amdgcn_mfma_f32_16x16x32_bf16(bf, pa, oacc[nt], 0, 0, 0);
            }
            asm volatile("s_waitcnt lgkmcnt(0)" ::: "memory");
        }
#pragma unroll
        for (int r = 0; r < 4; ++r) { const float ps = allsum16(lsum[r]); if (fr == 0) MSw[hq * 4 + r] = ps; }
        asm volatile("s_waitcnt lgkmcnt(0)" ::: "memory");
        const float inv = 1.0f / MSw[fr];
#pragma unroll
        for (int nt = 0; nt < 16; ++nt) { u32x2 wv; wv.x = pk2(oacc[nt][0] * inv, oacc[nt][1] * inv); wv.y = pk2(oacc[nt][2] * inv, oacc[nt][3] * inv); *(LAS u32x2*)(CSw + fr * 528 + (nt * 16 + hq * 4) * 2) = wv; }
        asm volatile("s_waitcnt lgkmcnt(0)" ::: "memory");
        bf16* op = qabs + tok * 4096 + lane * 8;
#pragma unroll
        for (int it = 0; it < 8; ++it) { const u32x4 ov = *(LAS u32x4*)(CSw + (2 * it + (lane >> 5)) * 528 + (lane & 31) * 16); __builtin_nontemporal_store(ov, (u32x4*)(op + it * 512)); }
        asm volatile("s_waitcnt lgkmcnt(0)" ::: "memory");
#undef DSA_LOAD_CH
    }
}

constexpr int DP_SC = 0, DP_SLAB = 65536, DP_SEL = DP_SLAB + 4 * DSA_WSLAB, DP_BIAS = DP_SEL + 4096, DP_FLG = DP_BIAS + 2048, DP_QI = DP_FLG + 256, DP_WI = DP_QI + 64 * 144;
static_assert(DP_SLAB >= 4 * 4096 * 4 && DP_WI + 256 <= LDS_BYTES - 256, "pipelined DSA LDS map");
__device__ __forceinline__ void lds_sig_add(volatile LAS int* p, int lane) { asm volatile("s_waitcnt lgkmcnt(0)" ::: "memory"); if (lane == 0) (void)__hip_atomic_fetch_add((LAS int*)p, 1, __ATOMIC_RELAXED, __HIP_MEMORY_SCOPE_WORKGROUP); }
__device__ __forceinline__ void lds_sig_set(volatile LAS int* p, int v, int lane) { asm volatile("s_waitcnt lgkmcnt(0)" ::: "memory"); if (lane == 0) *p = v; }
__device__ __forceinline__ void lds_wait_ge(volatile LAS int* p, int v) { while (__builtin_amdgcn_readfirstlane(*p) < v) __builtin_amdgcn_s_sleep(1); asm volatile("" ::: "memory"); }
__device__ __forceinline__ void dsa_phase(const Args& a, LAS unsigned char* lds, int bx) {
    const int tid = threadIdx.x, lane = tid & 63, w = __builtin_amdgcn_readfirstlane(tid >> 6);
    unsigned char* ws = a.ws;
    volatile LAS int* FLG = (volatile LAS int*)(lds + DP_FLG);
    LAS float* BIAS = (LAS float*)(lds + DP_BIAS);
    BIAS[tid] = a.in[I_RELB][tid];
    if (tid < 32) FLG[tid] = 0;
    __syncthreads();
    if (w < 4) {
        const int xw = w; int nx = 0, bb = (bx >> 2) & 1, nxt = 0; bool stolen = false;
        __builtin_amdgcn_s_setprio(2);
#define DSA_TICKET() ((int)__hip_atomic_fetch_add((unsigned*)(ws + WS_CTL + CTL_QUEUE + bb * 256), 1u, __ATOMIC_RELAXED, __HIP_MEMORY_SCOPE_AGENT))
#define X_BARRIER() do { ++nx; lds_sig_add(FLG + 8, lane); lds_wait_ge(FLG + 8, 4 * nx); } while (0)
#define DSA_PUBLISH(rr_) do { int u = __builtin_amdgcn_readfirstlane(nxt); \
            while (u >= 1024) { if (stolen) { u = -1; break; } stolen = true; bb ^= 1; int t = 0; if (lane == 0) t = DSA_TICKET(); u = __builtin_amdgcn_readfirstlane(t); } \
            if (lane == 0) { FLG[16 + ((rr_) & 3) * 2] = bb; FLG[17 + ((rr_) & 3) * 2] = (u < 0) ? -1 : 1023 - u; } \
            if (u >= 0 && lane == 0) nxt = DSA_TICKET(); } while (0)
        const bf16* qidxg = (const bf16*)(ws + WS_QIDX); const float* widxg = (const float*)(ws + WS_WIDX);
        LAS unsigned char* QI = lds + DP_QI; LAS float* WI = (LAS float*)(lds + DP_WI);
        u32x4 qv0 = (u32x4){0u, 0u, 0u, 0u}, qv1 = qv0; f32x4 wv4 = (f32x4){0.f, 0.f, 0.f, 0.f};
#define DSA_STAGE_LOAD(b_, q0_) do { const size_t tk_ = (size_t)(b_) * T + (q0_) + xw; qv0 = *(const u32x4*)(qidxg + tk_ * 1024 + lane * 8); qv1 = *(const u32x4*)(qidxg + tk_ * 1024 + 512 + lane * 8); \
            if (lane < 4) wv4 = *(const f32x4*)(widxg + tk_ * 16 + lane * 4); } while (0)
#define DSA_STAGE_STORE() do { const int h0_ = lane >> 3, h1_ = 8 + (lane >> 3), pc_ = lane & 7, tb_ = (xw >> 1) * 32 + ((xw & 1) << 2); \
            *(LAS u32x4*)(QI + (tb_ + ((h0_ & 3) | ((h0_ >> 2) << 3))) * 144 + pc_ * 16) = qv0; *(LAS u32x4*)(QI + (tb_ + ((h1_ & 3) | ((h1_ >> 2) << 3))) * 144 + pc_ * 16) = qv1; \
            if (lane < 4) *(LAS f32x4*)(WI + xw * 16 + lane * 4) = wv4; } while (0)
        if (xw == 0) { if (lane == 0) nxt = DSA_TICKET(); DSA_PUBLISH(0); }
        X_BARRIER();
        { const int b0 = __builtin_amdgcn_readfirstlane(FLG[16]), g0 = __builtin_amdgcn_readfirstlane(FLG[17]); if (g0 >= 0) { DSA_STAGE_LOAD(b0, g0 * 4); DSA_STAGE_STORE(); } }
        ++nx; lds_sig_add(FLG + 8, lane);
        for (int r = 0;; ++r) {
            const int b = __builtin_amdgcn_readfirstlane(FLG[16 + (r & 3) * 2]), qg4 = __builtin_amdgcn_readfirstlane(FLG[17 + (r & 3) * 2]);
            lds_wait_ge(FLG + 8, 4 * nx);
            if (qg4 < 0) { lds_sig_set(FLG + xw, r + 1, lane); break; }
            const int q0 = qg4 * 4, L = ((q0 >> 6) + 1) * 64;
            if (L > 256) dsa_scores4(a, (LAS float*)(lds + DP_SC), QI, WI, b, q0, L, xw, lane);
            if (xw == 0) {
                for (int y = 0; y < 4; ++y) lds_wait_ge(FLG + 4 + y, r - 1);
                DSA_PUBLISH(r + 1);
            }
            X_BARRIER();
            const int bn = __builtin_amdgcn_readfirstlane(FLG[16 + ((r + 1) & 3) * 2]), gn4 = __builtin_amdgcn_readfirstlane(FLG[17 + ((r + 1) & 3) * 2]);
            if (gn4 >= 0) DSA_STAGE_LOAD(bn, gn4 * 4);
            LAS unsigned short* SELr = (LAS unsigned short*)(lds + DP_SEL) + ((r & 1) * 4 + xw) * 256;
            dsa_select((LAS const float*)(lds + DP_SC) + xw * 4096, SELr, L, lane, []() { });
            lds_sig_set(FLG + xw, r + 1, lane);
            if (gn4 >= 0) DSA_STAGE_STORE();
            ++nx; lds_sig_add(FLG + 8, lane);
        }
#undef DSA_STAGE_LOAD
#undef DSA_STAGE_STORE
#undef DSA_PUBLISH
#undef DSA_TICKET
#undef X_BARRIER
        __builtin_amdgcn_s_setprio(0);
    } else {
        const int yw = w - 4;
        for (int r = 0;; ++r) {
            lds_wait_ge(FLG + yw, r + 1);
            const int b = __builtin_amdgcn_readfirstlane(FLG[16 + (r & 3) * 2]), qg4 = __builtin_amdgcn_readfirstlane(FLG[17 + (r & 3) * 2]);
            if (qg4 < 0) break;
            const int q0 = qg4 * 4, L = ((q0 >> 6) + 1) * 64, nk = L < 256 ? L : 256;
            dsa_attend(a, lds + DP_SLAB + yw * DSA_WSLAB, (LAS const unsigned short*)(lds + DP_SEL) + ((r & 1) * 4 + yw) * 256, BIAS, b, q0 + yw, nk, lane);
            lds_sig_set(FLG + 4 + yw, r + 1, lane);
        }
    }
    __syncthreads();
}

__device__ __forceinline__ void uv_phase(const Args& a, LAS unsigned char* lds, int h, int tt0, int tstep) {
    const int tid = threadIdx.x, lane = tid & 63, w = __builtin_amdgcn_readfirstlane(tid >> 6), mt = w & 3, nt = w >> 2, i = lane & 31, half = lane >> 5;
    unsigned char* ws = a.ws; const bf16* ol = (const bf16*)a.out; const bf16* wuvt = (const bf16*)(ws + WS_WUVT); const bf16* gates = (const bf16*)(ws + WS_GATES); bf16* mixed = (bf16*)(ws + WS_XN);
    constexpr int UP = 528; LAS unsigned char* Bs = lds; LAS unsigned char* As = lds + 64 * UP; LAS unsigned char* STs = lds + 64 * UP + 128 * UP;
#pragma unroll
    for (int p = 0; p < 4; ++p) { const int pc = tid + p * NTHREADS, r = pc >> 5, c = pc & 31; *(LAS u32x4*)(Bs + r * UP + c * 16) = *(const u32x4*)(wuvt + (size_t)(h * 64 + r) * KVR + c * 8); }
    u32x4 av[8], an[8];
    if (tt0 < M / 128) {
#pragma unroll
        for (int p = 0; p < 8; ++p) { const int pc = tid + p * NTHREADS; av[p] = __builtin_nontemporal_load((const u32x4*)(ol + ((size_t)tt0 * 128 + (pc >> 5)) * 4096 + h * 256 + (pc & 31) * 8)); }
    }
    for (int tt = tt0; tt < M / 128; tt += tstep) {
#pragma unroll
        for (int p = 0; p < 8; ++p) { const int pc = tid + p * NTHREADS; *(LAS u32x4*)(As + (pc >> 5) * UP + (pc & 31) * 16) = av[p]; }
        const int ttn = tt + tstep;
        if (ttn < M / 128) {
#pragma unroll
            for (int p = 0; p < 8; ++p) { const int pc = tid + p * NTHREADS; an[p] = __builtin_nontemporal_load((const u32x4*)(ol + ((size_t)ttn * 128 + (pc >> 5)) * 4096 + h * 256 + (pc & 31) * 8)); }
        }
        LDS_BARRIER();
        f32x16 acc;
#pragma unroll
        for (int j = 0; j < 16; ++j) acc[j] = 0.f;
#pragma unroll
        for (int ks = 0; ks < 16; ++ks) { const bf16x8 bd = *(LAS bf16x8*)(Bs + (nt * 32 + i) * UP + (ks * 16 + half * 8) * 2), at = *(LAS bf16x8*)(As + (mt * 32 + i) * UP + (ks * 16 + half * 8) * 2);
            acc = __builtin_amdgcn_mfma_f32_32x32x16_bf16(bd, at, acc, 0, 0, 0); }
        {   LAS unsigned char* strow = STs + (mt * 32 + i) * FP + (nt * 32 + 4 * half) * 4;
#pragma unroll
            for (int g = 0; g < 4; ++g) *(LAS f32x4*)(strow + 32 * g) = (f32x4){acc[4 * g], acc[4 * g + 1], acc[4 * g + 2], acc[4 * g + 3]}; }
        u32x4 gwv[2];
#pragma unroll
        for (int k = 0; k < 2; ++k) { const int pc = tid + k * NTHREADS; gwv[k] = *(const u32x4*)(gates + ((size_t)tt * 128 + (pc >> 3)) * 2048 + 1024 + h * 64 + (pc & 7) * 8); }
        LDS_BARRIER();
#pragma unroll
        for (int k = 0; k < 2; ++k) { const int pc = tid + k * NTHREADS, tk = pc >> 3, d8 = (pc & 7) * 8;
            const f32x4 y0 = *(LAS f32x4*)(STs + tk * FP + d8 * 4), y1 = *(LAS f32x4*)(STs + tk * FP + d8 * 4 + 16); const u32x4 gw = gwv[k];
            u32x4 ov; ov.x = pk2(y0[0] * bflo(gw.x), y0[1] * bfhi(gw.x)); ov.y = pk2(y0[2] * bflo(gw.y), y0[3] * bfhi(gw.y)); ov.z = pk2(y1[0] * bflo(gw.z), y1[1] * bfhi(gw.z)); ov.w = pk2(y1[2] * bflo(gw.w), y1[3] * bfhi(gw.w));
            *(u32x4*)(mixed + ((size_t)tt * 128 + tk) * 2048 + 1024 + h * 64 + d8) = ov; }
#pragma unroll
        for (int p = 0; p < 8; ++p) av[p] = an[p];
    }
}

__device__ __forceinline__ void phase8(const Args& a) {
    const int tid = threadIdx.x, lane = tid & 63, wave = tid >> 6, G = gridDim.x, bx = blockIdx.x;
    const float* part = (const float*)(a.ws + WS_PART); const float* g = a.in[I_FINALG]; float* out = a.out;
    for (int row = bx * NWAVES + wave; row < M; row += G * NWAVES) {
        float ss = (lane < 32) ? part[(size_t)row * 32 + lane] : 0.f; ss = wave_sum(ss);
        const float r = rsqrtf(ss * (1.0f / D) + 1e-6f); float* orow = out + (size_t)row * D;
#pragma unroll
        for (int i = 0; i < 8; ++i) { const int c = (i * 64 + lane) * 4; f32x4 v = *(const f32x4*)(orow + c); const f32x4 gg = *(const f32x4*)(g + c);
            v[0] = v[0] * r * gg[0]; v[1] = v[1] * r * gg[1]; v[2] = v[2] * r * gg[2]; v[3] = v[3] * r * gg[3]; *(f32x4*)(orow + c) = v; }
    }
}

#define XB_TMO      128
#define XB_XCNT(j)  (256  + 64 * (j))
#define XB_XSUB(j)  (1280 + 64 * (j))
#define XB_XGEN(j)  (2304 + 64 * (j))
#define XB_TOP      3328
#define XB_TOPGEN   3392
#define XCD_BAR_WORDS 3456
#define XB_SPIN_CAP (1u << 18)

__device__ __forceinline__ unsigned xb_ld(unsigned* p)              { return __hip_atomic_load(p, __ATOMIC_RELAXED, __HIP_MEMORY_SCOPE_AGENT); }
__device__ __forceinline__ unsigned xb_add(unsigned* p, unsigned v) { return __hip_atomic_fetch_add(p, v, __ATOMIC_RELAXED, __HIP_MEMORY_SCOPE_AGENT); }
__device__ __forceinline__ unsigned xb_xcc_id() { return (unsigned)__builtin_amdgcn_s_getreg((3 << 11) | 20) & 0xFu; }
#define XB_SPIN(cond, bar) do { unsigned _sp = 0; while (cond) { __builtin_amdgcn_s_sleep(1); \
    if ((++_sp & 255u) == 0u) { if (xb_ld(&(bar)[XB_TMO])) break; if (_sp > XB_SPIN_CAP) { atomicAdd(&(bar)[XB_TMO], 1u); break; } } } } while (0)

struct XcdBarrier {
    unsigned* bar; unsigned x;
    volatile LAS unsigned* st;
};

__device__ __forceinline__ XcdBarrier xcd_barrier_post(unsigned* bar, volatile LAS unsigned* st) {
    XcdBarrier b; b.bar = bar; b.x = xb_xcc_id(); b.st = st;
    if (threadIdx.x == 0) (void)xb_add(&bar[XB_XCNT(b.x)], 1u);
    return b;
}
__device__ __forceinline__ void xcd_barrier_complete(unsigned* bar, unsigned x, unsigned& nloc, unsigned& nx) {
    const unsigned G = gridDim.x * gridDim.y * gridDim.z;
    unsigned sum, cnt, mine, sp = 0u;
    for (;;) {
        sum = 0u; cnt = 0u; mine = 0u;
#pragma unroll
        for (unsigned j = 0; j < 16; ++j) { const unsigned c = xb_ld(&bar[XB_XCNT(j)]); sum += c; cnt += (c > 0u) ? 1u : 0u; mine = (j == x) ? c : mine; }
        if (sum == G) break;
        __builtin_amdgcn_s_sleep(1);
        if ((++sp & 255u) == 0u) { if (xb_ld(&bar[XB_TMO])) break; if (sp > XB_SPIN_CAP) { atomicAdd(&bar[XB_TMO], 1u); break; } }
    }
    nloc = mine > 0u ? mine : 1u; nx = cnt > 0u ? cnt : 1u;
}

__device__ __forceinline__ void xcd_barrier_arrive(const XcdBarrier& b) {
    asm volatile("s_waitcnt vmcnt(0)" ::: "memory");
    __syncthreads();
    if (threadIdx.x == 0) {
        unsigned* bar = b.bar;
        __builtin_amdgcn_s_waitcnt(0);
        unsigned nloc = b.st[0], nx = b.st[1];
        if (nloc == 0u) { xcd_barrier_complete(bar, b.x, nloc, nx); b.st[0] = nloc; b.st[1] = nx; }
        const unsigned old = xb_add(&bar[XB_XSUB(b.x)], 1u);
        const unsigned gen = old / nloc;
        if (old + 1u == (gen + 1u) * nloc) {
            __builtin_amdgcn_fence(__ATOMIC_RELEASE, "agent");
            asm volatile("s_waitcnt vmcnt(0)" ::: "memory");
            const unsigned og = xb_add(&bar[XB_TOP], 1u);
            const unsigned tg = og / nx;
            if (og + 1u == (tg + 1u) * nx) xb_add(&bar[XB_TOPGEN], 1u);
        }
    }
}
__device__ __forceinline__ void xcd_barrier_wait(const XcdBarrier& b) {
    if (threadIdx.x == 0) {
        unsigned* bar = b.bar; const unsigned target = b.st[2] + 1u;
        XB_SPIN((int)(xb_ld(&bar[XB_TOPGEN]) - target) < 0, bar);
        __builtin_amdgcn_fence(__ATOMIC_ACQUIRE, "agent");
        asm volatile("s_waitcnt vmcnt(0)" ::: "memory");
        b.st[2] = target;
    }
    __syncthreads();
}
__device__ __forceinline__ void xcd_barrier(const XcdBarrier& b) { xcd_barrier_arrive(b); xcd_barrier_wait(b); }

struct EpiOutFused {
    static constexpr bool PERM = true, AFTER_DRAIN = true;
    float* out; const pg8::bf16_t* hb; const pg8::bf16_t* ple; float* part; const float* g; const XcdBarrier* bar;
    __device__ __forceinline__ void fused(const pg8::f32x4 (&acc)[2][2][4][2], const pg8::Unit& u, int wr, int wc, int fr, int fq, PG8_LAS unsigned char*, int, int) const {
        using pg8::f32x4; using pg8::u32x4; constexpr int BM = pg8::BM, HALF = pg8::HALF;
        const int row0 = u.pm * BM + wr * 64 + fr, col0 = u.pn * BM + wc * 32 + 8 * fq;
        f32x4 val[2][2][4][2];
#pragma unroll
        for (int ai = 0; ai < 2; ++ai)
#pragma unroll
            for (int m = 0; m < 4; ++m) { const int row = row0 + ai * HALF + m * 16; const size_t ro = (size_t)row * 2048 + col0; float ss = 0.f;
#pragma unroll
                for (int bj = 0; bj < 2; ++bj) { const size_t o = ro + bj * HALF;
                    const u32x4 pw = __builtin_nontemporal_load((const u32x4*)(ple + o)), hw = __builtin_nontemporal_load((const u32x4*)(hb + o));
                    f32x4 p0, p1, v0, v1;
                    p0[0] = __builtin_bit_cast(float, pw.x << 16); p0[1] = __builtin_bit_cast(float, pw.x & 0xffff0000u); p0[2] = __builtin_bit_cast(float, pw.y << 16); p0[3] = __builtin_bit_cast(float, pw.y & 0xffff0000u);
                    p1[0] = __builtin_bit_cast(float, pw.z << 16); p1[1] = __builtin_bit_cast(float, pw.z & 0xffff0000u); p1[2] = __builtin_bit_cast(float, pw.w << 16); p1[3] = __builtin_bit_cast(float, pw.w & 0xffff0000u);
                    v0[0] = __builtin_bit_cast(float, hw.x << 16); v0[1] = __builtin_bit_cast(float, hw.x & 0xffff0000u); v0[2] = __builtin_bit_cast(float, hw.y << 16); v0[3] = __builtin_bit_cast(float, hw.y & 0xffff0000u);
                    v1[0] = __builtin_bit_cast(float, hw.z << 16); v1[1] = __builtin_bit_cast(float, hw.z & 0xffff0000u); v1[2] = __builtin_bit_cast(float, hw.w << 16); v1[3] = __builtin_bit_cast(float, hw.w & 0xffff0000u);
#pragma unroll
                    for (int j = 0; j < 4; ++j) { v0[j] += p0[j] * pg8::sigmoid_f(acc[ai][bj][m][0][j]); v1[j] += p1[j] * pg8::sigmoid_f(acc[ai][bj][m][1][j]); ss += v0[j] * v0[j] + v1[j] * v1[j]; }
                    val[ai][bj][m][0] = v0; val[ai][bj][m][1] = v1; }
                ss += __shfl_xor(ss, 16); ss += __shfl_xor(ss, 32);
                if (fq == 0) part[(size_t)row * 32 + u.pn * 4 + wc] = ss; }
        xcd_barrier(*bar);
#pragma unroll
        for (int ai = 0; ai < 2; ++ai)
#pragma unroll
            for (int m = 0; m < 4; ++m) { const int row = row0 + ai * HALF + m * 16; const float* pr = part + (size_t)row * 32; float tot = 0.f;
#pragma unroll
                for (int j = 0; j < 8; ++j) { const f32x4 pv = *(const f32x4*)(pr + 4 * j); tot += (pv[0] + pv[1]) + (pv[2] + pv[3]); }
                const float r = rsqrtf(tot * (1.0f / 2048.0f) + 1e-6f); const size_t ro = (size_t)row * 2048 + col0;
#pragma unroll
                for (int bj = 0; bj < 2; ++bj) { const f32x4 o0 = val[ai][bj][m][0] * r * *(const f32x4*)(g + col0 + bj * HALF), o1 = val[ai][bj][m][1] * r * *(const f32x4*)(g + col0 + bj * HALF + 4);
                    __builtin_nontemporal_store(o0, (f32x4*)(out + ro + bj * HALF)); __builtin_nontemporal_store(o1, (f32x4*)(out + ro + bj * HALF + 4)); } }
    }
};

__global__ void __launch_bounds__(NTHREADS, 2) mega_fwd(Args a) {
    extern __shared__ __attribute__((aligned(16))) unsigned char lds_raw[];
    LAS unsigned char* lds = (LAS unsigned char*)lds_raw;
    volatile LAS unsigned* bst = (volatile LAS unsigned*)(lds + LDS_BYTES - 16);
    if (threadIdx.x < 4) bst[threadIdx.x] = 0u;
    __syncthreads();
    const XcdBarrier bar = xcd_barrier_post((unsigned*)(a.ws + WS_CTL), bst);
    unsigned char* ws = a.ws; const int G = gridDim.x, bx = blockIdx.x;
    const int lo = a.ph_lo, hi = a.ph_hi;
#define IN(k) (lo <= (k) && (k) < hi)
#define STAMP(i) do { if (PROBE_TS >= 0 && bx == 0 && threadIdx.x == 0) ((volatile LAS unsigned long long*)(lds + LDS_BYTES - 256))[(i)] = __builtin_amdgcn_s_memrealtime(); } while (0)
#define SEAM(k) do { if (IN((k) + 1)) { xcd_barrier(bar); if (PROBE_DUP & 8) xcd_barrier(bar); } } while (0)
    STAMP(0);
    if (IN(0)) { phase0(a, lds); if (PROBE_DUP & 4) { __syncthreads(); phase0(a, lds); }
        if (IN(1)) { xcd_barrier_arrive(bar); wfold_prep(a); tr_run(a, lds, TR_WIN, TR_S1); xcd_barrier_wait(bar); } }
    STAMP(1);
    if (IN(1)) {
        pg8::Gemm g{(const pg8::bf16_t*)(ws + WS_XN), (const pg8::bf16_t*)(ws + WS_WINT), M, NZ, D}; pg8::StaticOrder S; S.init(M, NZ, G, bx);
        pg8::EpiZ E{(pg8::bf16_t*)(ws + WS_ZRKV), (pg8::bf16_t*)(ws + WS_GATES), (float*)(ws + WS_ZSM), (pg8::bf16_t*)(ws + WS_QLN), (float*)(ws + WS_QSS)};
        pg8::gemm_phase<pg8::EpiZ, pg8::StaticOrder, true, true>(lds, g, S, E);
        if (PROBE_DUP & 2) pg8::gemm_phase<pg8::EpiZ, pg8::StaticOrder, true, true>(lds, g, S, E);
        xcd_barrier_arrive(bar); tr_run(a, lds, TR_S1, TR_S2); xcd_barrier_wait(bar);
    }
    STAMP(2);
    STAMP(3);
    if (IN(3)) {
        pg8::Gemm g{(const pg8::bf16_t*)(ws + WS_QLN), (const pg8::bf16_t*)(ws + WS_WQIT), M, NQI, QR}; pg8::StaticOrder S; S.init(M, NQI, G, bx);
        pg8::EpiBf16Split E{(pg8::bf16_t*)a.out, 4096, 16, (pg8::bf16_t*)(ws + WS_QIDX), 1024};
        pg8::gemm_phase<pg8::EpiBf16Split, pg8::StaticOrder, true, true>(lds, g, S, E);
        { const int nfull = (M / 256) * (NQI / 256) % G; if (nfull == 0) phase2(a, bx, G); else if (bx >= nfull) phase2(a, bx - nfull, G - nfull); }
        __syncthreads();
    }
    STAMP(4);
    if (IN(4)) {
        for (int rep = 0; rep < ((PROBE_DUP & 1) ? 2 : 1); ++rep) rwkvA_phase(a, lds, bx & 15, bx >> 4, G >> 4);
        xcd_barrier_arrive(bar); tr_run(a, lds, TR_S2, TR_TOTAL); p_to_bf16(a); xcd_barrier_wait(bar);
    }
    STAMP(5);
    if (IN(5)) {
        if (bx < RW_WGS) { rwkvB_unit(a, lds, bx >> 4, bx & 15); if (PROBE_DUP & 32) rwkvB_unit(a, lds, bx >> 4, bx & 15); }
        STAMP(6);
        dsa_phase(a, lds, bx);
        STAMP(12);
        SEAM(5);
    }
    STAMP(7);
    if (IN(6)) { uv_phase(a, lds, bx & 15, bx >> 4, G >> 4); SEAM(6); }
    STAMP(8);
    if (IN(7)) {
        {   pg8::Gemm g{(const pg8::bf16_t*)(ws + WS_XN), (const pg8::bf16_t*)(ws + WS_WOUTT), M, D, D}; pg8::StaticOrder S; S.init(M, D, G, bx);
            pg8::EpiH E{a.in[I_X], (pg8::bf16_t*)(ws + WS_ZRKV)};
            pg8::gemm_phase<pg8::EpiH, pg8::StaticOrder, true, true>(lds, g, S, E); }
        xcd_barrier_arrive(bar);
        {   pg8::Gemm g{(const pg8::bf16_t*)(ws + WS_PBF), (const pg8::bf16_t*)(ws + WS_PLEWT), M, D, PLE}; pg8::StaticOrder S; S.init(M, D, G, bx);
            pg8::EpiBf16Split E{(pg8::bf16_t*)(ws + WS_GATES), 2048, 8, (pg8::bf16_t*)(ws + WS_GATES), 2048};
            pg8::gemm_phase<pg8::EpiBf16Split, pg8::StaticOrder, true, true>(lds, g, S, E); }
        xcd_barrier_wait(bar);
    }
    STAMP(9);
    const bool fuse_final = (G == 256) && IN(9);
    if (IN(8)) {
        pg8::Gemm g{(const pg8::bf16_t*)(ws + WS_ZRKV), (const pg8::bf16_t*)(ws + WS_WGATET), M, D, D}; pg8::StaticOrder S; S.init(M, D, G, bx);
        if (fuse_final) {
            EpiOutFused E{a.out, (const pg8::bf16_t*)(ws + WS_ZRKV), (const pg8::bf16_t*)(ws + WS_GATES), (float*)(ws + WS_PART), a.in[I_FINALG], &bar};
            pg8::gemm_phase<EpiOutFused, pg8::StaticOrder, false, true>(lds, g, S, E);
        } else {
            pg8::EpiOut E{a.out, (const pg8::bf16_t*)(ws + WS_ZRKV), (const pg8::bf16_t*)(ws + WS_GATES), (float*)(ws + WS_PART)};
            pg8::gemm_phase<pg8::EpiOut, pg8::StaticOrder, true, true>(lds, g, S, E);
            SEAM(8);
        }
    }
    STAMP(10);
    if (IN(9) && !fuse_final) phase8(a);
    STAMP(11);
    if (PROBE_TS >= 0 && bx == 0 && threadIdx.x == 0) { volatile LAS unsigned long long* ts = (volatile LAS unsigned long long*)(lds + LDS_BYTES - 256);
        const float us = (float)(ts[PROBE_TS2] - ts[PROBE_TS]) * 0.01f; __threadfence(); a.out[1] += us; }
}

#ifndef N_LAUNCHES
#define N_LAUNCHES 1
#endif
extern "C" void kernel_launch(void* const* d_in, const int* in_sizes, int n_in, void* d_out, int out_size, void* d_ws, size_t ws_size, hipStream_t stream) {
    static int grid = 0;
    if (grid == 0) {
        int dev = 0, cus = 0, per_cu = 0;
        if (n_in != 26 || out_size != M * D || ws_size < WS_END) { fprintf(stderr, "kernel_launch: unexpected shapes (n_in %d out %d ws %zu)\n", n_in, out_size, ws_size); grid = -1; return; }
        (void)hipGetDevice(&dev); (void)hipDeviceGetAttribute(&cus, hipDeviceAttributeMultiprocessorCount, dev);
        if (hipFuncSetAttribute((const void*)mega_fwd, hipFuncAttributeMaxDynamicSharedMemorySize, LDS_BYTES) != hipSuccess) { fprintf(stderr, "kernel_launch: hipFuncSetAttribute failed\n"); grid = -1; return; }
        if (hipOccupancyMaxActiveBlocksPerMultiprocessor(&per_cu, (const void*)mega_fwd, NTHREADS, LDS_BYTES) != hipSuccess || per_cu < 1) { fprintf(stderr, "kernel_launch: occupancy query says %d\n", per_cu); grid = -1; return; }
        grid = cus;
        fprintf(stderr, "kernel_launch: cus %d per_cu %d grid %d\n", cus, per_cu, grid);
    }
    if (grid < 0) return;
    Args a{};
    for (int i = 0; i < 26; ++i) a.in[i] = (const float*)d_in[i];
    a.out = (float*)d_out; a.ws = (unsigned char*)d_ws;
    const int NPH = 10;
    if (hipMemsetAsync((char*)d_ws + WS_CTL, 0, 16384, stream) != hipSuccess) { fprintf(stderr, "kernel_launch: hipMemsetAsync failed\n"); return; }
    for (int li = 0; li < N_LAUNCHES; ++li) {
        a.ph_lo = (N_LAUNCHES == 1) ? 0 : li; a.ph_hi = (N_LAUNCHES == 1) ? NPH : li + 1;
        void* args[] = {&a};
        const hipError_t e = hipLaunchCooperativeKernel((const void*)mega_fwd, dim3(grid), dim3(NTHREADS), args, LDS_BYTES, stream);
        if (e != hipSuccess) { fprintf(stderr, "kernel_launch: cooperative launch failed: %s (grid %d)\n", hipGetErrorString(e), grid); break; }
    }
}
```

```cpp
#include <hip/hip_runtime.h>
#include <hip/hip_cooperative_groups.h>
#include <cstdio>
#include <cstdint>
namespace cg = cooperative_groups;
#ifndef PROBE_DUP
#define PROBE_DUP 0
#endif
#ifndef PROBE_TS
#define PROBE_TS -1
#endif
#ifndef PROBE_TS2
#define PROBE_TS2 (PROBE_TS + 1)
#endif

__device__ __forceinline__ float sum_rows4(float x) {
    unsigned pu = __builtin_bit_cast(unsigned, x);
    { const auto sw = __builtin_amdgcn_permlane16_swap(pu, pu, false, false); x = __builtin_bit_cast(float, (unsigned)sw[0]) + __builtin_bit_cast(float, (unsigned)sw[1]); pu = __builtin_bit_cast(unsigned, x); }
    { const auto sw = __builtin_amdgcn_permlane32_swap(pu, pu, false, false); x = __builtin_bit_cast(float, (unsigned)sw[0]) + __builtin_bit_cast(float, (unsigned)sw[1]); }
    return x;
}
namespace pg8 {
#define PG8_LAS __attribute__((address_space(3)))
typedef unsigned short bf16_t;
typedef short bf16x8 __attribute__((ext_vector_type(8)));
typedef float f32x4 __attribute__((ext_vector_type(4)));
typedef unsigned u32x4 __attribute__((ext_vector_type(4)));
constexpr int BM = 256, BK = 64, HALF = 128, HTB = HALF * BK * 2  , STAGE_BYTES = 8 * HTB, NXCD = 8, WGM = 8;

__host__ __device__ __forceinline__ int lds_byte(int r, int c) { const int st = (r >> 4) * 2 + (c >> 5), rr = r & 15, cc = c & 31, ob = rr * 64 + cc * 2; return st * 1024 + (ob ^ (((ob >> 9) & 1) << 5)); }
__host__ __device__ __forceinline__ void stage_rc(int b, int& R, int& C) { const int st = b / 1024, sb = b % 1024, swz = sb ^ (((sb >> 9) & 1) << 5); R = (st >> 1) * 16 + swz / 64; C = (st & 1) * 32 + (swz % 64) / 2; }
__host__ __device__ __forceinline__ int perm32(int rho) { const int n = rho >> 4, i = rho & 15; return 8 * (i >> 2) + 4 * n + (i & 3); }

struct Unit { int pm, pn; };
struct Gemm { const bf16_t* A; const bf16_t* Bt; int M, N, K; };

struct StaticOrder {
    int nM, nN, nwg, G, c;
    __host__ __device__ void init(int M, int N, int G_, int c_) { nM = M / BM; nN = N / BM; nwg = nM * nN; G = G_; c = c_; }
    __host__ __device__ bool next(int i, Unit& u) const {
        const long L = (long)i * G + c; if (L >= nwg) return false;
        int wgid = (int)L; { const int q = nwg / NXCD, r = nwg % NXCD, xcd = wgid % NXCD, off = wgid / NXCD; wgid = (xcd < r ? xcd * (q + 1) : r * (q + 1) + (xcd - r) * q) + off; }
        const int nig = WGM * nN, gid = wgid / nig, fm = gid * WGM, gsz = (nM - fm) < WGM ? (nM - fm) : WGM;
        u.pm = fm + ((wgid % nig) % gsz); u.pn = (wgid % nig) / gsz; return true;
    }
    __device__ __forceinline__ void a_ready(const Unit&) const {}
    __device__ __forceinline__ void done(const Unit&) const {}
};

typedef float f32x2v_t __attribute__((ext_vector_type(2)));
typedef __bf16 bf16x2v_t __attribute__((ext_vector_type(2)));
__device__ __forceinline__ unsigned cvt_pk_bf16(float lo, float hi) { const f32x2v_t v = {lo, hi}; const bf16x2v_t b = __builtin_convertvector(v, bf16x2v_t); return __builtin_bit_cast(unsigned, b); }
__device__ __forceinline__ float silu_f(float v) { return v * __builtin_amdgcn_rcpf(1.0f + __expf(-v)); }
__device__ __forceinline__ float sigmoid_f(float v) { return __builtin_amdgcn_rcpf(1.0f + __expf(-v)); }
__device__ __forceinline__ u32x4 pack8(const f32x4& v0, const f32x4& v1) { u32x4 w; w.x = cvt_pk_bf16(v0[0], v0[1]); w.y = cvt_pk_bf16(v0[2], v0[3]); w.z = cvt_pk_bf16(v1[0], v1[1]); w.w = cvt_pk_bf16(v1[2], v1[3]); return w; }

struct EpiZ {
    static constexpr bool PERM = true, AFTER_DRAIN = false;
    bf16_t* zrkv; bf16_t* gates; float* zsm; bf16_t* qln; float* qss;
    __device__ __forceinline__ void operator()(const f32x4 (&acc)[2][2][4][2], const Unit& u, int wr, int wc, int fr, int fq) const {
        const int row0 = u.pm * BM + wr * 64 + fr, colw = wc * 32 + 8 * fq;
        if (u.pn < 12) {
#pragma unroll
            for (int ai = 0; ai < 2; ++ai)
#pragma unroll
                for (int m = 0; m < 4; ++m) { bf16_t* rowp = zrkv + (size_t)(row0 + ai * HALF + m * 16) * 3072 + u.pn * BM + colw;
#pragma unroll
                    for (int bj = 0; bj < 2; ++bj) *(u32x4*)(rowp + bj * HALF) = pack8(acc[ai][bj][m][0], acc[ai][bj][m][1]); }
        } else if (u.pn < 20) {
#pragma unroll
            for (int ai = 0; ai < 2; ++ai)
#pragma unroll
                for (int m = 0; m < 4; ++m) { bf16_t* rowp = gates + (size_t)(row0 + ai * HALF + m * 16) * 2048 + (u.pn - 12) * BM + colw;
#pragma unroll
                    for (int bj = 0; bj < 2; ++bj) { f32x4 v0 = acc[ai][bj][m][0], v1 = acc[ai][bj][m][1];
#pragma unroll
                        for (int j = 0; j < 4; ++j) { v0[j] = silu_f(v0[j]); v1[j] = silu_f(v1[j]); }
                        *(u32x4*)(rowp + bj * HALF) = pack8(v0, v1); } }
        } else {
#pragma unroll
            for (int ai = 0; ai < 2; ++ai)
#pragma unroll
                for (int m = 0; m < 4; ++m) { float* rowp = zsm + (size_t)(row0 + ai * HALF + m * 16) * 1024 + (u.pn - 20) * BM + colw;
#pragma unroll
                    for (int bj = 0; bj < 2; ++bj) { if (u.pn == 21 || (bj == 1 && u.pn != 22)) continue;
                        *(f32x4*)(rowp + bj * HALF) = acc[ai][bj][m][0]; *(f32x4*)(rowp + bj * HALF + 4) = acc[ai][bj][m][1]; } }
            if (u.pn == 20 || u.pn == 21) {
                const int bj0 = (u.pn == 20) ? 1 : 0, qc0 = (u.pn == 20) ? colw - HALF : 128 + colw;
#pragma unroll
                for (int ai = 0; ai < 2; ++ai)
#pragma unroll
                    for (int m = 0; m < 4; ++m) { const int row = row0 + ai * HALF + m * 16; float ss = 0.f;
                        for (int bj = bj0; bj < 2; ++bj) { const f32x4 v0 = acc[ai][bj][m][0], v1 = acc[ai][bj][m][1];
                            ss += v0[0] * v0[0] + v0[1] * v0[1] + v0[2] * v0[2] + v0[3] * v0[3] + v1[0] * v1[0] + v1[1] * v1[1] + v1[2] * v1[2] + v1[3] * v1[3];
                            *(u32x4*)(qln + (size_t)row * 384 + qc0 + bj * HALF) = pack8(v0, v1); }
                        ss = sum_rows4(ss);
                        if (fq == 0) qss[(size_t)row * 8 + (u.pn - 20) * 4 + wc] = ss; }
            }
        }
    }
};
struct EpiBf16Split {
    static constexpr bool PERM = true, AFTER_DRAIN = false;
    bf16_t* O0; int ld0; int nt0; bf16_t* O1; int ld1; bool stream0 = false;
    __device__ __forceinline__ void operator()(const f32x4 (&acc)[2][2][4][2], const Unit& u, int wr, int wc, int fr, int fq) const {
        const int row0 = u.pm * BM + wr * 64 + fr, colw = wc * 32 + 8 * fq;
        bf16_t* base; int ld, ct;
        if (u.pn < nt0) { base = O0; ld = ld0; ct = u.pn; } else { base = O1; ld = ld1; ct = u.pn - nt0; }
#pragma unroll
        for (int ai = 0; ai < 2; ++ai)
#pragma unroll
            for (int m = 0; m < 4; ++m) { bf16_t* rowp = base + (size_t)(row0 + ai * HALF + m * 16) * ld + ct * BM + colw;
#pragma unroll
                for (int bj = 0; bj < 2; ++bj) { const u32x4 pw = pack8(acc[ai][bj][m][0], acc[ai][bj][m][1]); if (stream0 && u.pn < nt0) __builtin_nontemporal_store(pw, (u32x4*)(rowp + bj * HALF)); else *(u32x4*)(rowp + bj * HALF) = pw; } }
    }
};
struct EpiH {
    static constexpr bool PERM = true, AFTER_DRAIN = false;
    const float* x; bf16_t* hb;
    __device__ __forceinline__ void operator()(const f32x4 (&acc)[2][2][4][2], const Unit& u, int wr, int wc, int fr, int fq) const {
        const int row0 = u.pm * BM + wr * 64 + fr, col0 = u.pn * BM + wc * 32 + 8 * fq;
#pragma unroll
        for (int ai = 0; ai < 2; ++ai)
#pragma unroll
            for (int m = 0; m < 4; ++m) { const size_t ro = (size_t)(row0 + ai * HALF + m * 16) * 2048 + col0;
#pragma unroll
                for (int bj = 0; bj < 2; ++bj) { const size_t o = ro + bj * HALF;
                    const f32x4 v0 = acc[ai][bj][m][0] + __builtin_nontemporal_load((const f32x4*)(x + o)), v1 = acc[ai][bj][m][1] + __builtin_nontemporal_load((const f32x4*)(x + o + 4));
                    *(u32x4*)(hb + o) = pack8(v0, v1); } }
    }
};
struct EpiOut {
    static constexpr bool PERM = true, AFTER_DRAIN = false;
    float* out; const bf16_t* hb; const bf16_t* ple; float* part;
    __device__ __forceinline__ void operator()(const f32x4 (&acc)[2][2][4][2], const Unit& u, int wr, int wc, int fr, int fq) const {
        const int row0 = u.pm * BM + wr * 64 + fr, col0 = u.pn * BM + wc * 32 + 8 * fq;
#pragma unroll
        for (int ai = 0; ai < 2; ++ai)
#pragma unroll
            for (int m = 0; m < 4; ++m) { const int row = row0 + ai * HALF + m * 16; const size_t ro = (size_t)row * 2048 + col0; float ss = 0.f;
#pragma unroll
                for (int bj = 0; bj < 2; ++bj) { const size_t o = ro + bj * HALF;
                    const u32x4 pw = __builtin_nontemporal_load((const u32x4*)(ple + o)), hw = *(const u32x4*)(hb + o);
                    f32x4 p0, p1, v0, v1;
                    p0[0] = __builtin_bit_cast(float, pw.x << 16); p0[1] = __builtin_bit_cast(float, pw.x & 0xffff0000u); p0[2] = __builtin_bit_cast(float, pw.y << 16); p0[3] = __builtin_bit_cast(float, pw.y & 0xffff0000u);
                    p1[0] = __builtin_bit_cast(float, pw.z << 16); p1[1] = __builtin_bit_cast(float, pw.z & 0xffff0000u); p1[2] = __builtin_bit_cast(float, pw.w << 16); p1[3] = __builtin_bit_cast(float, pw.w & 0xffff0000u);
                    v0[0] = __builtin_bit_cast(float, hw.x << 16); v0[1] = __builtin_bit_cast(float, hw.x & 0xffff0000u); v0[2] = __builtin_bit_cast(float, hw.y << 16); v0[3] = __builtin_bit_cast(float, hw.y & 0xffff0000u);
                    v1[0] = __builtin_bit_cast(float, hw.z << 16); v1[1] = __builtin_bit_cast(float, hw.z & 0xffff0000u); v1[2] = __builtin_bit_cast(float, hw.w << 16); v1[3] = __builtin_bit_cast(float, hw.w & 0xffff0000u);
#pragma unroll
                    for (int j = 0; j < 4; ++j) { v0[j] += p0[j] * sigmoid_f(acc[ai][bj][m][0][j]); v1[j] += p1[j] * sigmoid_f(acc[ai][bj][m][1][j]); ss += v0[j] * v0[j] + v1[j] * v1[j]; }
                    *(f32x4*)(out + o) = v0; *(f32x4*)(out + o + 4) = v1; }
                ss = sum_rows4(ss);
                if (fq == 0) part[(size_t)row * 32 + u.pn * 4 + wc] = ss; }
    }
};

template <class Epi, class Sched, bool ALIGN_EPI = false, bool SP2 = false>
__device__ __forceinline__ void gemm_phase(PG8_LAS unsigned char* lds, const Gemm g, const Sched& S, const Epi& E) {
    const int tid = threadIdx.x, wid = __builtin_amdgcn_readfirstlane(tid >> 6), lane = tid & 63, wr = wid >> 2, wc = wid & 3, fr = lane & 15, fq = lane >> 4;
    const int K = g.K, nt = K / BK;
    unsigned voffA[2], voffB[2];
#pragma unroll
    for (int i = 0; i < 2; ++i) { int R, C; stage_rc(tid * 16 + i * 8192, R, C); const int Rb = Epi::PERM ? ((R & ~31) + perm32(R & 31)) : R;
        voffA[i] = (unsigned)(R * K + C) * 2u; voffB[i] = (unsigned)(Rb * K + C) * 2u; }
    const size_t kstep = (size_t)(BK * 2);
    const size_t hstep = (size_t)HALF * K * 2;
    const size_t tstep = 2 * hstep;
    const unsigned ldsw = (unsigned)wid * 1024u;
    const int aoff = lds_byte(wr * 64 + fr, fq * 8), boff = lds_byte(wc * 32 + fr, fq * 8);
#define PG8_SA(b, h) (((b) * 2 + (h)) * HTB)
#define PG8_SB(b, h) ((4 + (b) * 2 + (h)) * HTB)
#define PG8_STAGE(bufoff, gbase, voff) do { _Pragma("unroll") for (int _i = 0; _i < 2; ++_i) \
        __builtin_amdgcn_global_load_lds((const unsigned*)((const char*)(gbase) + (voff)[_i]), (PG8_LAS unsigned*)(lds + (bufoff) + ldsw + _i * 8192), 16, 0, 0); } while (0)
#define PG8_LDA(dst, b, h) do { _Pragma("unroll") for (int m = 0; m < 4; ++m) _Pragma("unroll") for (int k = 0; k < 2; ++k) dst[m][k] = *(const PG8_LAS bf16x8*)(lds + PG8_SA(b, h) + aoff + m * 2048 + k * 1024); } while (0)
#define PG8_LDB(dst, b, h) do { _Pragma("unroll") for (int n = 0; n < 2; ++n) _Pragma("unroll") for (int k = 0; k < 2; ++k) dst[n][k] = *(const PG8_LAS bf16x8*)(lds + PG8_SB(b, h) + boff + n * 2048 + k * 1024); } while (0)
#define PG8_MMA(ai, bj, At, Bt) do { __builtin_amdgcn_s_setprio(1); _Pragma("unroll") for (int m = 0; m < 4; ++m) _Pragma("unroll") for (int n = 0; n < 2; ++n) _Pragma("unroll") for (int k = 0; k < 2; ++k) \
        acc[ai][bj][m][n] = __builtin_amdgcn_mfma_f32_16x16x32_bf16(Bt[n][k], At[m][k], acc[ai][bj][m][n], 0, 0, 0); __builtin_amdgcn_s_setprio(0); } while (0)
#define PG8_WAIT_V(n) asm volatile("s_waitcnt vmcnt(" #n ")" ::: "memory")
#define PG8_WAIT_L(n) asm volatile("s_waitcnt lgkmcnt(" #n ")" ::: "memory")
#define PG8_BAR __builtin_amdgcn_s_barrier()
#define PG8_SCHED __builtin_amdgcn_sched_barrier(0)
    Unit cur, nxt; int ui = 0;
    if (!S.next(0, cur)) return;
    f32x4 acc[2][2][4][2];
#pragma unroll
    for (int a = 0; a < 2; ++a)
#pragma unroll
        for (int b = 0; b < 2; ++b)
#pragma unroll
            for (int m = 0; m < 4; ++m)
#pragma unroll
                for (int n = 0; n < 2; ++n) acc[a][b][m][n] = (f32x4){0.f, 0.f, 0.f, 0.f};
    bf16x8 At[4][2], B0[2][2], B1[2][2];
    const char* cA = (const char*)g.A + (size_t)cur.pm * tstep; const char* cB = (const char*)g.Bt + (size_t)cur.pn * tstep;
    S.a_ready(cur);
    if constexpr (SP2) {
        PG8_STAGE(PG8_SB(0, 0), cB, voffB); PG8_STAGE(PG8_SB(0, 1), cB + hstep, voffB); PG8_STAGE(PG8_SA(0, 0), cA, voffA); PG8_STAGE(PG8_SA(0, 1), cA + hstep, voffA);
        if (wr == 1) PG8_BAR;
        PG8_WAIT_V(2); PG8_BAR;
        PG8_STAGE(PG8_SB(1, 0), cB + kstep, voffB); PG8_STAGE(PG8_SA(1, 0), cA + kstep, voffA); PG8_STAGE(PG8_SB(1, 1), cB + hstep + kstep, voffB);
        PG8_WAIT_V(6); PG8_BAR;
    } else {
        PG8_STAGE(PG8_SB(0, 0), cB, voffB); PG8_STAGE(PG8_SA(0, 0), cA, voffA); PG8_STAGE(PG8_SB(0, 1), cB + hstep, voffB); PG8_STAGE(PG8_SA(0, 1), cA + hstep, voffA);
        if (wr == 1) PG8_BAR;
        PG8_WAIT_V(4); PG8_BAR;
        PG8_STAGE(PG8_SB(1, 0), cB + kstep, voffB); PG8_STAGE(PG8_SA(1, 0), cA + kstep, voffA); PG8_STAGE(PG8_SB(1, 1), cB + hstep + kstep, voffB);
        PG8_WAIT_V(6); PG8_BAR;
    }
    for (;;) {
        const bool has_next = S.next(ui + 1, nxt);
        const char* nA = has_next ? (const char*)g.A + (size_t)nxt.pm * tstep : cA; const char* nB = has_next ? (const char*)g.Bt + (size_t)nxt.pn * tstep : cB;
        for (int t = 0; t < nt; t += 2) {
            const bool last = (t == nt - 2);
            const char* a1 = cA + (size_t)(t + 1) * kstep;
            const char* a2 = last ? nA : cA + (size_t)(t + 2) * kstep; const char* b2 = last ? nB : cB + (size_t)(t + 2) * kstep;
            const char* a3 = a2 + kstep; const char* b3 = b2 + kstep;
            if (last && has_next) S.a_ready(nxt);
            if constexpr (SP2) {
            PG8_LDB(B0, 0, 0); PG8_LDB(B1, 0, 1); PG8_SCHED; PG8_LDA(At, 0, 0); PG8_STAGE(PG8_SA(1, 1), a1 + hstep, voffA);
            PG8_WAIT_V(8); PG8_WAIT_L(0); PG8_BAR; PG8_MMA(0, 0, At, B0); PG8_MMA(0, 1, At, B1); PG8_BAR; PG8_SCHED;
            PG8_LDA(At, 0, 1); PG8_STAGE(PG8_SB(0, 0), b2, voffB); PG8_STAGE(PG8_SB(0, 1), b2 + hstep, voffB); PG8_STAGE(PG8_SA(0, 0), a2, voffA);
            PG8_WAIT_V(8); PG8_WAIT_L(0); PG8_BAR; PG8_MMA(1, 0, At, B0); PG8_MMA(1, 1, At, B1); PG8_BAR; PG8_SCHED;
            PG8_LDB(B0, 1, 0); PG8_LDB(B1, 1, 1); PG8_SCHED; PG8_LDA(At, 1, 0); PG8_STAGE(PG8_SA(0, 1), a2 + hstep, voffA);
            PG8_WAIT_V(8); PG8_WAIT_L(0); PG8_BAR; PG8_MMA(0, 0, At, B0); PG8_MMA(0, 1, At, B1); PG8_BAR; PG8_SCHED;
            PG8_LDA(At, 1, 1); PG8_STAGE(PG8_SB(1, 0), b3, voffB); PG8_STAGE(PG8_SB(1, 1), b3 + hstep, voffB); PG8_STAGE(PG8_SA(1, 0), a3, voffA);
            PG8_WAIT_V(8); PG8_WAIT_L(0); PG8_BAR; PG8_MMA(1, 0, At, B0); PG8_MMA(1, 1, At, B1); PG8_BAR; PG8_SCHED;
            } else {
            PG8_LDB(B0, 0, 0); PG8_SCHED; PG8_LDA(At, 0, 0); PG8_STAGE(PG8_SA(1, 1), a1 + hstep, voffA);
            PG8_WAIT_L(8); PG8_BAR; PG8_WAIT_L(0); PG8_MMA(0, 0, At, B0); PG8_BAR; PG8_SCHED;
            PG8_LDB(B1, 0, 1); PG8_STAGE(PG8_SB(0, 0), b2, voffB);
            PG8_BAR; PG8_WAIT_L(0); PG8_MMA(0, 1, At, B1); PG8_BAR;
            PG8_LDA(At, 0, 1); PG8_STAGE(PG8_SA(0, 0), a2, voffA);
            PG8_BAR; PG8_WAIT_L(0); PG8_MMA(1, 0, At, B0); PG8_BAR; PG8_SCHED;
            PG8_STAGE(PG8_SB(0, 1), b2 + hstep, voffB);
            PG8_WAIT_V(6); PG8_BAR; PG8_MMA(1, 1, At, B1); PG8_BAR;
            PG8_LDB(B0, 1, 0); PG8_SCHED; PG8_LDA(At, 1, 0); PG8_STAGE(PG8_SA(0, 1), a2 + hstep, voffA);
            PG8_WAIT_L(8); PG8_BAR; PG8_WAIT_L(0); PG8_MMA(0, 0, At, B0); PG8_BAR; PG8_SCHED;
            PG8_LDB(B1, 1, 1); PG8_STAGE(PG8_SB(1, 0), b3, voffB);
            PG8_BAR; PG8_WAIT_L(0); PG8_MMA(0, 1, At, B1); PG8_BAR;
            PG8_LDA(At, 1, 1); PG8_STAGE(PG8_SA(1, 0), a3, voffA);
            PG8_BAR; PG8_WAIT_L(0); PG8_MMA(1, 0, At, B0); PG8_BAR; PG8_SCHED;
            PG8_STAGE(PG8_SB(1, 1), b3 + hstep, voffB);
            PG8_WAIT_V(6); PG8_BAR; PG8_MMA(1, 1, At, B1); PG8_BAR;
            }
        }
        if constexpr (ALIGN_EPI) { if (wr == 0) PG8_BAR; }
        if constexpr (!Epi::AFTER_DRAIN) { E(acc, cur, wr, wc, fr, fq); S.done(cur); }
        if (!has_next) break;
#pragma unroll
        for (int a = 0; a < 2; ++a)
#pragma unroll
            for (int b = 0; b < 2; ++b)
#pragma unroll
                for (int m = 0; m < 4; ++m)
#pragma unroll
                    for (int n = 0; n < 2; ++n) acc[a][b][m][n] = (f32x4){0.f, 0.f, 0.f, 0.f};
        cur = nxt; cA = nA; cB = nB; ++ui;
        if constexpr (ALIGN_EPI) { if (wr == 1) PG8_BAR; }
    }
    PG8_WAIT_V(0);
    if constexpr (!ALIGN_EPI) { if (wr == 0) PG8_BAR; }
    PG8_BAR;
    if constexpr (Epi::AFTER_DRAIN) { E.fused(acc, cur, wr, wc, fr, fq, lds, wid, lane); S.done(cur); }
#undef PG8_SA
#undef PG8_SB
#undef PG8_STAGE
#undef PG8_LDA
#undef PG8_LDB
#undef PG8_MMA
#undef PG8_WAIT_V
#undef PG8_WAIT_L
#undef PG8_BAR
#undef PG8_SCHED
}
}

constexpr int NB = 2, T = 4096, M = NB * T, D = 2048, DIN = 5968, NZ = 6144, PLE = 256;
constexpr int QR = 384, KVR = 256, NQI = 5120;
constexpr int NWAVES = 8, NTHREADS = 512;
constexpr int LDS_BYTES = 163840;
constexpr int RW_WGS = 32;
constexpr size_t MiB = 1u << 20;
constexpr size_t WS_CTL = 0;
constexpr size_t WS_WINT = 1 * MiB;
constexpr size_t WS_WOUTT = 25 * MiB;
constexpr size_t WS_WGATET = 33 * MiB;
constexpr size_t WS_PLEWT = 41 * MiB;
constexpr size_t WS_WQIT = 42 * MiB;
constexpr size_t WS_WUVT = 46 * MiB;
constexpr size_t WS_PBF = 47 * MiB;
constexpr size_t WS_XN = 51 * MiB;
constexpr size_t WS_ZRKV = 83 * MiB;
constexpr size_t WS_GATES = 131 * MiB;
constexpr size_t WS_ZSM = 163 * MiB;
constexpr size_t WS_QLN = 195 * MiB;
constexpr size_t WS_CKV = 201 * MiB;
constexpr size_t WS_KIDX = 205 * MiB;
constexpr size_t WS_WIDX = 206 * MiB;
constexpr size_t WS_QIDX = 207 * MiB;
constexpr size_t WS_PART = 223 * MiB;
constexpr size_t WS_RWR = 1 * MiB;
constexpr size_t WS_QRI = 19 * MiB;
constexpr size_t WS_QSS = 256 * 1024;
constexpr size_t WS_RBC = 17 * MiB;
constexpr size_t WS_RG = 224 * MiB;
constexpr size_t WS_RSL = 240 * MiB;
constexpr size_t WS_END = 256 * MiB;
constexpr size_t CTL_QUEUE = 15872;
constexpr int ZS_WD = 0, ZS_AD = 64, ZS_QL = 128, ZS_KV = 512, ZS_KI = 768, ZS_WI = 832;
#define YLOC_OFF(h_) ((h_) < 12 ? 512 + (h_) * 128 : 3392 + ((h_) - 12) * 128)

#define LAS __attribute__((address_space(3)))
typedef unsigned short bf16;
typedef float f32x4 __attribute__((ext_vector_type(4)));
typedef float f32x16 __attribute__((ext_vector_type(16)));
typedef short bf16x8 __attribute__((ext_vector_type(8)));
typedef short s16x4 __attribute__((ext_vector_type(4)));
typedef unsigned u32x4 __attribute__((ext_vector_type(4)));
typedef unsigned u32x2 __attribute__((ext_vector_type(2)));

__device__ __forceinline__ unsigned f2bf(float f) { unsigned u = __builtin_bit_cast(unsigned, f); return (u + 0x7fffu + ((u >> 16) & 1u)) >> 16; }
typedef float f32x2_t __attribute__((ext_vector_type(2)));
typedef __bf16 bf16x2_t __attribute__((ext_vector_type(2)));
__device__ __forceinline__ unsigned pk2(float lo, float hi) { const f32x2_t v = {lo, hi}; const bf16x2_t b = __builtin_convertvector(v, bf16x2_t); return __builtin_bit_cast(unsigned, b); }
__device__ __forceinline__ float bflo(unsigned w) { return __builtin_bit_cast(float, w << 16); }
__device__ __forceinline__ float bfhi(unsigned w) { return __builtin_bit_cast(float, w & 0xffff0000u); }
__device__ __forceinline__ float bf1(bf16 v) { return __builtin_bit_cast(float, (unsigned)v << 16); }
#define LDS_BARRIER() do { asm volatile("s_waitcnt lgkmcnt(0)" ::: "memory"); __builtin_amdgcn_s_barrier(); asm volatile("" ::: "memory"); } while (0)
template <int CTRL> __device__ __forceinline__ float dppf(float x) { return __builtin_bit_cast(float, __builtin_amdgcn_update_dpp(0, __builtin_bit_cast(int, x), CTRL, 0xF, 0xF, true)); }
__device__ __forceinline__ float allsum8(float x) { x += dppf<0xB1>(x); x += dppf<0x4E>(x); x += dppf<0x141>(x); return x; }
__device__ __forceinline__ float allsum16(float x) { x = allsum8(x); x += dppf<0x140>(x); return x; }
__device__ __forceinline__ float allmax16(float x) { x = fmaxf(x, dppf<0xB1>(x)); x = fmaxf(x, dppf<0x4E>(x)); x = fmaxf(x, dppf<0x141>(x)); x = fmaxf(x, dppf<0x140>(x)); return x; }
__device__ __forceinline__ float wave_sum(float v) {
    v += __builtin_bit_cast(float, __builtin_amdgcn_update_dpp(0, __builtin_bit_cast(int, v), 0xB1, 0xF, 0xF, true)); v += __builtin_bit_cast(float, __builtin_amdgcn_update_dpp(0, __builtin_bit_cast(int, v), 0x4E, 0xF, 0xF, true));
    v += __builtin_bit_cast(float, __builtin_amdgcn_update_dpp(0, __builtin_bit_cast(int, v), 0x141, 0xF, 0xF, true)); v += __builtin_bit_cast(float, __builtin_amdgcn_update_dpp(0, __builtin_bit_cast(int, v), 0x140, 0xF, 0xF, true));
    return sum_rows4(v);
}

struct Args { const float* in[26]; float* out; unsigned char* ws; int ph_lo, ph_hi; };
enum { I_X = 0, I_P, I_WIN, I_NORMG, I_MU, I_W0, I_WUP, I_A0, I_AUP, I_KK, I_KA, I_RK, I_LNG, I_LNB, I_QNG, I_KVNG, I_IKNG, I_WUQ, I_WUK, I_WUV, I_IWQ, I_RELB, I_WOUT, I_PLEW, I_WGATE, I_FINALG };

__device__ __forceinline__ int win_src_col(int n) {
    if (n < 3072) return n;
    if (n < 4096) return n - 3072 + 3200;
    if (n < 5120) return n - 4096 + 4944;
    if (n < 5248) return n - 5120 + 3072;
    if (n < 5632) return n - 5248 + 4224;
    if (n < 5888) return n - 5632 + 4608;
    if (n < 5952) return n - 5888 + 4864;
    if (n < 5968) return n - 5952 + 4928;
    return -1;
}
struct TrTile { const float* src; bf16* dst; const float* kscale; int ldsrc, K, n0, k0, sc; };
constexpr int TR_WIN = (NZ / 64) * (D / 64), TR_CRIT = (NZ / 64) * (D / 64) + (1024 / 64) * (QR / 64), TR_TOTAL = TR_CRIT + 2 * (D / 64) * (D / 64) + (D / 64) * (PLE / 64) + (1024 / 64) * (KVR / 64), TR_S1 = TR_CRIT + (TR_TOTAL - TR_CRIT) / 3, TR_S2 = TR_CRIT + 2 * (TR_TOTAL - TR_CRIT) / 3;
__device__ __forceinline__ bool tr_item(const Args& a, int it, int hi, int tid, TrTile& t) {
    unsigned char* ws = a.ws;
    const int n_win = (NZ / 64) * (D / 64), n_sq = (D / 64) * (D / 64), n_ple = (D / 64) * (PLE / 64), n_iwq = (1024 / 64) * (QR / 64), n_wuv = (1024 / 64) * (KVR / 64);
    const int total = n_win + 2 * n_sq + n_ple + n_iwq + n_wuv;
    if (it >= hi || it >= total) return false;
    int nt, kt; bool win = false; t.kscale = nullptr;
    if (it < n_win) { t.src = a.in[I_WIN]; t.ldsrc = DIN; t.K = D; t.dst = (bf16*)(ws + WS_WINT); nt = it / (D / 64); kt = it % (D / 64); win = true; }
    else if ((it -= n_win) < n_iwq) { t.src = a.in[I_IWQ]; t.ldsrc = 1024; t.K = QR; t.dst = (bf16*)(ws + WS_WQIT) + (size_t)4096 * QR; nt = it / (QR / 64); kt = it % (QR / 64); t.kscale = a.in[I_QNG]; }
    else if ((it -= n_iwq) < n_sq) { t.src = a.in[I_WOUT]; t.ldsrc = D; t.K = D; t.dst = (bf16*)(ws + WS_WOUTT); nt = it / (D / 64); kt = it % (D / 64); }
    else if ((it -= n_sq) < n_sq) { t.src = a.in[I_WGATE]; t.ldsrc = D; t.K = D; t.dst = (bf16*)(ws + WS_WGATET); nt = it / (D / 64); kt = it % (D / 64); }
    else if ((it -= n_sq) < n_ple) { t.src = a.in[I_PLEW]; t.ldsrc = D; t.K = PLE; t.dst = (bf16*)(ws + WS_PLEWT); nt = it / (PLE / 64); kt = it % (PLE / 64); }
    else { it -= n_ple; t.src = a.in[I_WUV]; t.ldsrc = 1024; t.K = KVR; t.dst = (bf16*)(ws + WS_WUVT); nt = it / (KVR / 64); kt = it % (KVR / 64); }
    t.n0 = nt * 64; t.k0 = kt * 64; const int c4 = (tid & 15) * 4; t.sc = win ? win_src_col(t.n0 + c4) : (t.n0 + c4);
    return true;
}
__device__ __forceinline__ void tr_load(const TrTile& t, int tid, f32x4& v0, f32x4& v1) {
    const int kr = tid >> 4; v0 = (f32x4){0.f, 0.f, 0.f, 0.f}; v1 = v0;
    if (t.sc >= 0) { v0 = __builtin_nontemporal_load((const f32x4*)(t.src + (size_t)(t.k0 + kr) * t.ldsrc + t.sc)); v1 = __builtin_nontemporal_load((const f32x4*)(t.src + (size_t)(t.k0 + kr + 32) * t.ldsrc + t.sc)); }
}

__device__ __forceinline__ void tr_run(const Args& a, LAS unsigned char* lds, int lo, int hi) {
    const int tid = threadIdx.x, G = gridDim.x, bx = blockIdx.x; LAS float* scr = (LAS float*)lds;
    {   TrTile cur, nxt; f32x4 v0, v1, n0v, n1v; int item = lo + bx, par = 0;
        bool have = tr_item(a, item, hi, tid, cur);
        if (have) tr_load(cur, tid, v0, v1);
        while (have) {
            item += G; const bool hn = tr_item(a, item, hi, tid, nxt);
            if (hn) tr_load(nxt, tid, n0v, n1v);
            LAS float* sb = scr + par * (64 * 65); par ^= 1;
            { const int kr = tid >> 4, c4 = (tid & 15) * 4;
              sb[kr * 65 + c4 + 0] = v0[0]; sb[kr * 65 + c4 + 1] = v0[1]; sb[kr * 65 + c4 + 2] = v0[2]; sb[kr * 65 + c4 + 3] = v0[3];
              sb[(kr + 32) * 65 + c4 + 0] = v1[0]; sb[(kr + 32) * 65 + c4 + 1] = v1[1]; sb[(kr + 32) * 65 + c4 + 2] = v1[2]; sb[(kr + 32) * 65 + c4 + 3] = v1[3]; }
            LDS_BARRIER();
            { const int n = tid >> 3, kq = (tid & 7) * 8; float v[8];
#pragma unroll
              for (int j = 0; j < 8; ++j) v[j] = sb[(kq + j) * 65 + n];
              if (cur.kscale) {
#pragma unroll
                  for (int j = 0; j < 8; ++j) v[j] *= cur.kscale[cur.k0 + kq + j]; }
              u32x4 wv; wv.x = pk2(v[0], v[1]); wv.y = pk2(v[2], v[3]); wv.z = pk2(v[4], v[5]); wv.w = pk2(v[6], v[7]);
              *(u32x4*)(cur.dst + (size_t)(cur.n0 + n) * cur.K + cur.k0 + kq) = wv; }
            cur = nxt; v0 = n0v; v1 = n1v; have = hn;
        }
        LDS_BARRIER();
    }
}

__device__ __forceinline__ void p_to_bf16(const Args& a) {
    const int tid = threadIdx.x, G = gridDim.x, bx = blockIdx.x; unsigned char* ws = a.ws;
    {   const float* p = a.in[I_P]; bf16* pb = (bf16*)(ws + WS_PBF);
        for (int i = bx * NTHREADS + tid; i < M * PLE / 4; i += G * NTHREADS) { const f32x4 v = __builtin_nontemporal_load((const f32x4*)(p + (size_t)i * 4)); u32x2 w; w.x = pk2(v[0], v[1]); w.y = pk2(v[2], v[3]); *(u32x2*)(pb + (size_t)i * 4) = w; }
    }
}

__device__ __forceinline__ void wfold_prep(const Args& a) {
    const int tid = threadIdx.x, lane = tid & 63, wave = tid >> 6, G = gridDim.x, bx = blockIdx.x; unsigned char* ws = a.ws;
    {   const float* wuq = a.in[I_WUQ]; const float* wuk = a.in[I_WUK]; bf16* wq = (bf16*)(ws + WS_WQIT);
        const int i = lane & 31, half = lane >> 5;
        for (int u = G - 1 - bx; u < 128; u += G) { const int h = u >> 3, rblk = u & 7;
            bf16x8 af[4];
#pragma unroll
            for (int ks = 0; ks < 4; ++ks) { const float* pa = wuk + (size_t)(rblk * 32 + i) * 1024 + h * 64 + ks * 16 + half * 8; const f32x4 x0 = *(const f32x4*)pa, x1 = *(const f32x4*)(pa + 4);
                u32x4 wv; wv.x = pk2(x0[0], x0[1]); wv.y = pk2(x0[2], x0[3]); wv.z = pk2(x1[0], x1[1]); wv.w = pk2(x1[2], x1[3]); af[ks] = __builtin_bit_cast(bf16x8, wv); }
            for (int kblk = wave; kblk < QR / 32; kblk += NWAVES) { f32x16 acc; const float gqk = 0.125f * a.in[I_QNG][kblk * 32 + i];
#pragma unroll
                for (int j = 0; j < 16; ++j) acc[j] = 0.f;
#pragma unroll
                for (int ks = 0; ks < 4; ++ks) { const float* pb = wuq + (size_t)(kblk * 32 + i) * 1024 + h * 64 + ks * 16 + half * 8; const f32x4 x0 = *(const f32x4*)pb, x1 = *(const f32x4*)(pb + 4);
                    u32x4 wv; wv.x = pk2(x0[0], x0[1]); wv.y = pk2(x0[2], x0[3]); wv.z = pk2(x1[0], x1[1]); wv.w = pk2(x1[2], x1[3]);
                    acc = __builtin_amdgcn_mfma_f32_32x32x16_bf16(af[ks], __builtin_bit_cast(bf16x8, wv), acc, 0, 0, 0); }
#pragma unroll
                for (int r = 0; r < 16; ++r) { const int rr = (r & 3) + 8 * (r >> 2) + 4 * half; wq[(size_t)(h * 256 + rblk * 32 + rr) * QR + kblk * 32 + i] = (bf16)f2bf(acc[r] * gqk); }
            }
        }
    }
}

__device__ __forceinline__ void phase0(const Args& a, LAS unsigned char* lds) {
    const int tid = threadIdx.x, lane = tid & 63, wave = tid >> 6, G = gridDim.x, bx = blockIdx.x;
    unsigned char* ws = a.ws; LAS float* scr = (LAS float*)lds;
    tr_run(a, lds, 0, TR_WIN);
    {   const float* x = a.in[I_X]; const float* g = a.in[I_NORMG]; bf16* xn = (bf16*)(ws + WS_XN);
        int row = bx * NWAVES + wave; f32x4 v[8], vn[8], gv[8];
#pragma unroll
        for (int i = 0; i < 8; ++i) gv[i] = *(const f32x4*)(g + (i * 64 + lane) * 4);
        if (row < M) {
#pragma unroll
            for (int i = 0; i < 8; ++i) v[i] = __builtin_nontemporal_load((const f32x4*)(x + (size_t)row * D + (i * 64 + lane) * 4));
        }
        for (; row < M; row += G * NWAVES) {
            const int rown = row + G * NWAVES;
            if (rown < M) {
#pragma unroll
                for (int i = 0; i < 8; ++i) vn[i] = __builtin_nontemporal_load((const f32x4*)(x + (size_t)rown * D + (i * 64 + lane) * 4));
            }
            float ss = 0.f;
#pragma unroll
            for (int i = 0; i < 8; ++i) ss += v[i][0] * v[i][0] + v[i][1] * v[i][1] + v[i][2] * v[i][2] + v[i][3] * v[i][3];
            ss = wave_sum(ss); const float r = rsqrtf(ss * (1.0f / D) + 1e-6f);
#pragma unroll
            for (int i = 0; i < 8; ++i) { const f32x4 gg = gv[i]; u32x2 w; w.x = pk2(v[i][0] * r * gg[0], v[i][1] * r * gg[1]); w.y = pk2(v[i][2] * r * gg[2], v[i][3] * r * gg[3]);
                *(u32x2*)(xn + (size_t)row * D + (i * 64 + lane) * 4) = w; }
#pragma unroll
            for (int i = 0; i < 8; ++i) v[i] = vn[i];
        }
    }
}

__device__ __forceinline__ void phase2(const Args& a, int bx, int G) {
    const int tid = threadIdx.x, lane = tid & 63, wave = tid >> 6;
    unsigned char* ws = a.ws; const float* zsm = (const float*)(ws + WS_ZSM);
    bf16* qln = (bf16*)(ws + WS_QLN); bf16* ckv = (bf16*)(ws + WS_CKV); bf16* kidx = (bf16*)(ws + WS_KIDX); float* widx = (float*)(ws + WS_WIDX);
    const float* gq = a.in[I_QNG]; const float* gkv = a.in[I_KVNG]; const float* gik = a.in[I_IKNG];
    for (int row = bx * NWAVES + wave; row < M; row += G * NWAVES) {
        const float* zr = zsm + (size_t)row * 1024;
        { const f32x4 v = __builtin_nontemporal_load((const f32x4*)(zr + ZS_KV + lane * 4)); float ss = v[0] * v[0] + v[1] * v[1] + v[2] * v[2] + v[3] * v[3];
          ss = wave_sum(ss); const float r = rsqrtf(ss * (1.0f / KVR) + 1e-6f); const f32x4 gg = *(const f32x4*)(gkv + lane * 4);
          u32x2 w; w.x = pk2(v[0] * r * gg[0], v[1] * r * gg[1]); w.y = pk2(v[2] * r * gg[2], v[3] * r * gg[3]); *(u32x2*)(ckv + (size_t)row * KVR + lane * 4) = w; }
        { const float v = __builtin_nontemporal_load(zr + ZS_KI + lane); float ss = wave_sum(v * v); const float r = rsqrtf(ss * (1.0f / 64) + 1e-6f);
          kidx[((((size_t)row >> 5) * 4 + (lane >> 4)) * 64 + ((lane >> 3) & 1) * 32 + (row & 31)) * 8 + (lane & 7)] = (bf16)f2bf(v * r * gik[lane]); }
        if (lane < 16) widx[(size_t)row * 16 + lane] = zr[ZS_WI + lane] * (1.0f / 32.0f);
    }
}

constexpr int RC_WUP = 0, RC_AUP = 9216, RC_S0 = 18432, RC_AT = 27648, RC_RT = 36864, RC_BT = 46080, RC_KT = 55296, RC_VT = 64512, RC_XA = 73728, RC_XB = 82944, RC_TA = 92160, RC_TB = 101376,
              RC_MAK = 110592, RC_NRB = 119808, RC_NRK = 129024, RC_VEC = 138240, RC_CST = 139008;
constexpr int RC_WPRE = RC_XA, RC_APRE = RC_TA, RC_LW = RC_MAK, RC_TOT = RC_NRK, RC_WDT = RC_AT, RC_ADT = RC_RT, RC_YF = RC_XA;
constexpr int MP = 144, FP = 272;
__device__ __forceinline__ float softplus_f(float x) { return fmaxf(x, 0.f) + __logf(1.0f + __expf(-fabsf(x))); }
__device__ __forceinline__ float tanh_fast(float x) { const float e = __expf(2.0f * x); return 1.0f - 2.0f * __builtin_amdgcn_rcpf(1.0f + e); }
__device__ __forceinline__ bf16x8 ld_contig(LAS const unsigned char* Mx, int row, int k0) { return *(LAS const bf16x8*)(Mx + row * MP + k0 * 2); }
__device__ __forceinline__ bf16x8 ld_tr(LAS const unsigned char* Mx, int krow0, int col0, int q, int p) {
    LAS const unsigned char* base = Mx + (krow0 + q) * MP + (col0 + 4 * p) * 2;
    const s16x4 lo = __builtin_amdgcn_ds_read_tr16_b64_v4i16((LAS s16x4*)(base));
    const s16x4 hi = __builtin_amdgcn_ds_read_tr16_b64_v4i16((LAS s16x4*)(base + 4 * MP));
    return (bf16x8){lo[0], lo[1], lo[2], lo[3], hi[0], hi[1], hi[2], hi[3]};
}
template <bool A_TR, bool B_TR> __device__ __forceinline__ void mm_acc(f32x16& acc, LAS const unsigned char* A, LAS const unsigned char* B, int rb, int cb, int lane) {
    const int l31 = lane & 31, kh = lane >> 5, q = (lane & 15) >> 2, p = lane & 3, cblk = ((lane >> 4) & 1) * 16;
#pragma unroll
    for (int ks = 0; ks < 4; ++ks) { const int k0 = ks * 16 + 8 * kh;
        const bf16x8 qf = A_TR ? ld_tr(A, k0, 32 * rb + cblk, q, p) : ld_contig(A, 32 * rb + l31, k0);
        const bf16x8 pf = B_TR ? ld_tr(B, k0, 32 * cb + cblk, q, p) : ld_contig(B, 32 * cb + l31, k0);
        acc = __builtin_amdgcn_mfma_f32_32x32x16_bf16(pf, qf, acc, 0, 0, 0); }
}
__device__ __forceinline__ void st_tile_bf16(LAS unsigned char* Dm, const f32x16& acc, int rb, int cb, int lane) {
    LAS unsigned char* rowp = Dm + (32 * rb + (lane & 31)) * MP + (32 * cb + 4 * (lane >> 5)) * 2;
#pragma unroll
    for (int g = 0; g < 4; ++g) { u32x2 w; w.x = pk2(acc[4 * g], acc[4 * g + 1]); w.y = pk2(acc[4 * g + 2], acc[4 * g + 3]); *(LAS u32x2*)(rowp + 16 * g) = w; }
}
__device__ __forceinline__ void st_tile_f32(LAS unsigned char* Dm, const f32x16& acc, int rb, int cb, int lane) {
    LAS unsigned char* rowp = Dm + (32 * rb + (lane & 31)) * FP + (32 * cb + 4 * (lane >> 5)) * 4;
#pragma unroll
    for (int g = 0; g < 4; ++g) *(LAS f32x4*)(rowp + 32 * g) = (f32x4){acc[4 * g], acc[4 * g + 1], acc[4 * g + 2], acc[4 * g + 3]};
}
template <bool INCL> __device__ __forceinline__ void mask_tril(f32x16& acc, int rb, int cb, int lane) {
    const int row = 32 * rb + (lane & 31);
#pragma unroll
    for (int j = 0; j < 16; ++j) { const int col = 32 * cb + (j & 3) + 8 * (j >> 2) + 4 * (lane >> 5); if (INCL ? (col > row) : (col >= row)) acc[j] = 0.f; }
}
__device__ __forceinline__ f32x16 zero16() { f32x16 z;
#pragma unroll
    for (int j = 0; j < 16; ++j) z[j] = 0.f;
    return z; }

__device__ __forceinline__ void st_tile_bf16_g(bf16* Dm, int pitch, const f32x16& acc, int rb, int cb, int lane) {
    bf16* rowp = Dm + (size_t)(32 * rb + (lane & 31)) * pitch + 32 * cb + 4 * (lane >> 5);
#pragma unroll
    for (int g = 0; g < 4; ++g) { u32x2 w; w.x = pk2(acc[4 * g], acc[4 * g + 1]); w.y = pk2(acc[4 * g + 2], acc[4 * g + 3]); *(u32x2*)(rowp + 8 * g) = w; }
}
__device__ __forceinline__ f32x16 ld_tile_bf16_g(const bf16* Dm, int pitch, int rb, int cb, int lane) {
    const bf16* rowp = Dm + (size_t)(32 * rb + (lane & 31)) * pitch + 32 * cb + 4 * (lane >> 5); f32x16 r;
#pragma unroll
    for (int g = 0; g < 4; ++g) { const u32x2 w = *(const u32x2*)(rowp + 8 * g); r[4 * g] = bflo(w.x); r[4 * g + 1] = bfhi(w.x); r[4 * g + 2] = bflo(w.y); r[4 * g + 3] = bfhi(w.y); }
    return r;
}
__device__ __forceinline__ void rwkvA_phase(const Args& a, LAS unsigned char* lds, int h, int p0, int pstep) {
    const int tid = threadIdx.x, lane = tid & 63, w = __builtin_amdgcn_readfirstlane(tid >> 6);
    unsigned char* ws = a.ws;
    const bf16* zrkv = (const bf16*)(ws + WS_ZRKV); const float* zsm = (const float*)(ws + WS_ZSM);
    for (int i = tid; i < 64 * 8; i += NTHREADS) { const int r = i >> 3, c = (i & 7) * 8;
        const f32x4 w0v = *(const f32x4*)(a.in[I_WUP] + (size_t)r * 1024 + h * 64 + c), w1v = *(const f32x4*)(a.in[I_WUP] + (size_t)r * 1024 + h * 64 + c + 4);
        const f32x4 a0v = *(const f32x4*)(a.in[I_AUP] + (size_t)r * 1024 + h * 64 + c), a1v = *(const f32x4*)(a.in[I_AUP] + (size_t)r * 1024 + h * 64 + c + 4);
        u32x4 pw; pw.x = pk2(w0v[0], w0v[1]); pw.y = pk2(w0v[2], w0v[3]); pw.z = pk2(w1v[0], w1v[1]); pw.w = pk2(w1v[2], w1v[3]);
        u32x4 pa; pa.x = pk2(a0v[0], a0v[1]); pa.y = pk2(a0v[2], a0v[3]); pa.z = pk2(a1v[0], a1v[1]); pa.w = pk2(a1v[2], a1v[3]);
        *(LAS u32x4*)(lds + RC_WUP + r * MP + c * 2) = pw; *(LAS u32x4*)(lds + RC_AUP + r * MP + c * 2) = pa; }
    const int pt = tid >> 3, c8 = (tid & 7) * 8, ch = h * 64 + c8;
    if (tid < 64) { LAS float* cst = (LAS float*)(lds + RC_CST); const int hc = h * 64 + tid;
        cst[0 * 64 + tid] = a.in[I_MU][hc]; cst[1 * 64 + tid] = a.in[I_MU][1024 + hc]; cst[2 * 64 + tid] = a.in[I_MU][2048 + hc]; cst[3 * 64 + tid] = a.in[I_MU][3072 + tid]; cst[4 * 64 + tid] = a.in[I_MU][3136 + tid];
        cst[5 * 64 + tid] = a.in[I_W0][hc]; cst[6 * 64 + tid] = a.in[I_A0][hc]; cst[7 * 64 + tid] = a.in[I_KK][hc]; cst[8 * 64 + tid] = a.in[I_KA][hc]; cst[9 * 64 + tid] = a.in[I_RK][hc];
        cst[10 * 64 + tid] = a.in[I_LNG][hc]; cst[11 * 64 + tid] = a.in[I_LNB][hc]; }
#define CSTV(name, idx) float name[8]; { const f32x4 _c0 = *(LAS f32x4*)(lds + RC_CST + (idx) * 256 + c8 * 4), _c1 = *(LAS f32x4*)(lds + RC_CST + (idx) * 256 + c8 * 4 + 16); \
        name[0] = _c0[0]; name[1] = _c0[1]; name[2] = _c0[2]; name[3] = _c0[3]; name[4] = _c1[0]; name[5] = _c1[1]; name[6] = _c1[2]; name[7] = _c1[3]; }
    const int wq = w & 3, rb = wq >> 1, cb = wq & 1;
    __syncthreads();
#define RA_FETCH_Z(p_, rc_, kc_, vc_, rp_, kq_, vp_) do { const int b_ = (p_) >> 6, ck_ = (p_) & 63, tp_ = ck_ * 64 + pt; const size_t tk_ = (size_t)b_ * T + tp_; \
        const bf16* zr_ = zrkv + tk_ * 3072 + ch; rc_ = __builtin_nontemporal_load((const u32x4*)(zr_)); kc_ = __builtin_nontemporal_load((const u32x4*)(zr_ + 1024)); vc_ = __builtin_nontemporal_load((const u32x4*)(zr_ + 2048)); \
        rp_ = (u32x4){0u, 0u, 0u, 0u}; kq_ = rp_; vp_ = rp_; \
        if (tp_ > 0) { rp_ = *(const u32x4*)(zr_ - 3072); kq_ = *(const u32x4*)(zr_ - 3072 + 1024); vp_ = *(const u32x4*)(zr_ - 3072 + 2048); } } while (0)
#define RA_FETCH_W(p_, wdc0_, wdc1_, adc0_, adc1_, wdp0_, wdp1_, adp0_, adp1_) do { const int b_ = (p_) >> 6, ck_ = (p_) & 63, tp_ = ck_ * 64 + pt; const size_t tk_ = (size_t)b_ * T + tp_; \
        wdp0_ = (f32x4){0.f, 0.f, 0.f, 0.f}; wdp1_ = wdp0_; adp0_ = wdp0_; adp1_ = wdp0_; \
        const float* zs_ = zsm + tk_ * 1024; wdc0_ = *(const f32x4*)(zs_ + ZS_WD + c8); wdc1_ = *(const f32x4*)(zs_ + ZS_WD + c8 + 4); adc0_ = *(const f32x4*)(zs_ + ZS_AD + c8); adc1_ = *(const f32x4*)(zs_ + ZS_AD + c8 + 4); \
        if (tp_ > 0) { wdp0_ = *(const f32x4*)(zs_ - 1024 + ZS_WD + c8); wdp1_ = *(const f32x4*)(zs_ - 1024 + ZS_WD + c8 + 4); adp0_ = *(const f32x4*)(zs_ - 1024 + ZS_AD + c8); adp1_ = *(const f32x4*)(zs_ - 1024 + ZS_AD + c8 + 4); } } while (0)
    u32x4 rc, kc, vc, rp, kq, vp;
    if (p0 < 128) RA_FETCH_Z(p0, rc, kc, vc, rp, kq, vp);
    for (int pr = p0; pr < 128; pr += pstep) {
        const int b = pr >> 6, ck = pr & 63; const size_t unit = ((size_t)(b * 16 + h)) * 64 + ck;
        float rs[8], kk[8], kp[8], vs[8], lwv[8], av[8], bc;
        {
            f32x4 wdc0, wdc1, adc0, adc1, wdp0, wdp1, adp0, adp1;
            RA_FETCH_W(pr, wdc0, wdc1, adc0, adc1, wdp0, wdp1, adp0, adp1);
            float wds[8], ads[8];
            CSTV(mu_r, 0) CSTV(mu_k, 1) CSTV(mu_v, 2) CSTV(mu_wd, 3) CSTV(mu_ad, 4)
#pragma unroll
            for (int j = 0; j < 4; ++j) {
                const unsigned rw = j == 0 ? rc.x : j == 1 ? rc.y : j == 2 ? rc.z : rc.w, rpw = j == 0 ? rp.x : j == 1 ? rp.y : j == 2 ? rp.z : rp.w;
                const unsigned kw = j == 0 ? kc.x : j == 1 ? kc.y : j == 2 ? kc.z : kc.w, kpw = j == 0 ? kq.x : j == 1 ? kq.y : j == 2 ? kq.z : kq.w;
                const unsigned vw = j == 0 ? vc.x : j == 1 ? vc.y : j == 2 ? vc.z : vc.w, vpw = j == 0 ? vp.x : j == 1 ? vp.y : j == 2 ? vp.z : vp.w;
                rs[2 * j] = bflo(rw) + mu_r[2 * j] * (bflo(rpw) - bflo(rw)); rs[2 * j + 1] = bfhi(rw) + mu_r[2 * j + 1] * (bfhi(rpw) - bfhi(rw));
                kk[2 * j] = bflo(kw) + mu_k[2 * j] * (bflo(kpw) - bflo(kw)); kk[2 * j + 1] = bfhi(kw) + mu_k[2 * j + 1] * (bfhi(kpw) - bfhi(kw));
                vs[2 * j] = bflo(vw) + mu_v[2 * j] * (bflo(vpw) - bflo(vw)); vs[2 * j + 1] = bfhi(vw) + mu_v[2 * j + 1] * (bfhi(vpw) - bfhi(vw));
                wds[j] = wdc0[j] + mu_wd[j] * (wdp0[j] - wdc0[j]); wds[4 + j] = wdc1[j] + mu_wd[4 + j] * (wdp1[j] - wdc1[j]);
                ads[j] = adc0[j] + mu_ad[j] * (adp0[j] - adc0[j]); ads[4 + j] = adc1[j] + mu_ad[4 + j] * (adp1[j] - adc1[j]); }
            u32x4 pw, pa; pw.x = pk2(tanh_fast(wds[0]), tanh_fast(wds[1])); pw.y = pk2(tanh_fast(wds[2]), tanh_fast(wds[3])); pw.z = pk2(tanh_fast(wds[4]), tanh_fast(wds[5])); pw.w = pk2(tanh_fast(wds[6]), tanh_fast(wds[7]));
            pa.x = pk2(ads[0], ads[1]); pa.y = pk2(ads[2], ads[3]); pa.z = pk2(ads[4], ads[5]); pa.w = pk2(ads[6], ads[7]);
            *(LAS u32x4*)(lds + RC_WDT + pt * MP + c8 * 2) = pw; *(LAS u32x4*)(lds + RC_ADT + pt * MP + c8 * 2) = pa;
        }
        LDS_BARRIER();
        {
            f32x16 acc = zero16();
            if (w < 4) { mm_acc<false, true>(acc, lds + RC_WDT, lds + RC_WUP, rb, cb, lane); st_tile_f32(lds + RC_WPRE, acc, rb, cb, lane); }
            else       { mm_acc<false, true>(acc, lds + RC_ADT, lds + RC_AUP, rb, cb, lane); st_tile_f32(lds + RC_APRE, acc, rb, cb, lane); }
        }
        LDS_BARRIER();
        {
            const f32x4 wp0 = *(LAS f32x4*)(lds + RC_WPRE + pt * FP + c8 * 4), wp1 = *(LAS f32x4*)(lds + RC_WPRE + pt * FP + c8 * 4 + 16);
            const f32x4 ap0 = *(LAS f32x4*)(lds + RC_APRE + pt * FP + c8 * 4), ap1 = *(LAS f32x4*)(lds + RC_APRE + pt * FP + c8 * 4 + 16);
            float n2 = 0.f; bc = 0.f; float ksv[8];
            CSTV(w0, 5) CSTV(a0, 6) CSTV(k_k, 7) CSTV(k_a, 8) CSTV(r_k, 9)
#pragma unroll
            for (int j = 0; j < 8; ++j) { const float wp = w0[j] + (j < 4 ? wp0[j & 3] : wp1[j & 3]), ap = a0[j] + (j < 4 ? ap0[j & 3] : ap1[j & 3]);
                lwv[j] = -0.60653065971263342f * __builtin_amdgcn_rcpf(1.0f + __expf(-wp));        av[j] = __builtin_amdgcn_rcpf(1.0f + __expf(-ap));
                ksv[j] = kk[j]; kk[j] = ksv[j] * k_k[j]; n2 += kk[j] * kk[j]; }
            n2 = allsum8(n2); const float inv = fminf(__builtin_amdgcn_rsqf(n2), 1e12f);
#pragma unroll
            for (int j = 0; j < 8; ++j) { kk[j] *= inv; kp[j] = ksv[j] * (1.0f + (av[j] - 1.0f) * k_a[j]); bc += rs[j] * kp[j] * r_k[j]; }
            bc = allsum8(bc);
            if ((tid & 7) == 0) ((float*)(ws + WS_RBC))[unit * 64 + pt] = bc;
            *(LAS f32x4*)(lds + RC_LW + pt * FP + c8 * 4) = (f32x4){lwv[0], lwv[1], lwv[2], lwv[3]}; *(LAS f32x4*)(lds + RC_LW + pt * FP + c8 * 4 + 16) = (f32x4){lwv[4], lwv[5], lwv[6], lwv[7]};
        }
        LDS_BARRIER();
        {
            const int kc = tid & 63, g = tid >> 6; float pre[8];
#pragma unroll
            for (int j = 0; j < 8; ++j) pre[j] = *(LAS const float*)(lds + RC_LW + (8 * g + j) * FP + kc * 4);
#pragma unroll
            for (int j = 1; j < 8; ++j) pre[j] += pre[j - 1];
            *(LAS float*)(lds + RC_TOT + g * 256 + kc * 4) = pre[7];
            LDS_BARRIER();
            float tv[8];
#pragma unroll
            for (int gg = 0; gg < 8; ++gg) tv[gg] = *(LAS const float*)(lds + RC_TOT + gg * 256 + kc * 4);
            float off = 0.f;
#pragma unroll
            for (int gg = 0; gg < 8; ++gg) off += (gg < g) ? tv[gg] : 0.f;
#pragma unroll
            for (int j = 0; j < 8; ++j) *(LAS float*)(lds + RC_LW + (8 * g + j) * FP + kc * 4) = pre[j] + off;
        }
        LDS_BARRIER();
        {
            const f32x4 c0 = *(LAS f32x4*)(lds + RC_LW + pt * FP + c8 * 4), c1 = *(LAS f32x4*)(lds + RC_LW + pt * FP + c8 * 4 + 16);
            const f32x4 m0 = *(LAS f32x4*)(lds + RC_LW + 31 * FP + c8 * 4), m1 = *(LAS f32x4*)(lds + RC_LW + 31 * FP + c8 * 4 + 16);
            float at[8], rt[8], bt[8], kt[8];
#pragma unroll
            for (int j = 0; j < 8; ++j) { const float cin = j < 4 ? c0[j & 3] : c1[j & 3], mm = j < 4 ? m0[j & 3] : m1[j & 3];
                const float er = __expf(cin - mm), ea = er * __expf(-lwv[j]), eb = __builtin_amdgcn_rcpf(er);
                at[j] = -kk[j] * ea; rt[j] = rs[j] * er; bt[j] = kk[j] * av[j] * eb; kt[j] = kp[j] * eb; }
            u32x4 pw;
            pw.x = pk2(at[0], at[1]); pw.y = pk2(at[2], at[3]); pw.z = pk2(at[4], at[5]); pw.w = pk2(at[6], at[7]); *(LAS u32x4*)(lds + RC_AT + pt * MP + c8 * 2) = pw;
            pw.x = pk2(rt[0], rt[1]); pw.y = pk2(rt[2], rt[3]); pw.z = pk2(rt[4], rt[5]); pw.w = pk2(rt[6], rt[7]); *(LAS u32x4*)(lds + RC_RT + pt * MP + c8 * 2) = pw;
            pw.x = pk2(bt[0], bt[1]); pw.y = pk2(bt[2], bt[3]); pw.z = pk2(bt[4], bt[5]); pw.w = pk2(bt[6], bt[7]); *(LAS u32x4*)(lds + RC_BT + pt * MP + c8 * 2) = pw;
            pw.x = pk2(kt[0], kt[1]); pw.y = pk2(kt[2], kt[3]); pw.z = pk2(kt[4], kt[5]); pw.w = pk2(kt[6], kt[7]); *(LAS u32x4*)(lds + RC_KT + pt * MP + c8 * 2) = pw;
            pw.x = pk2(vs[0], vs[1]); pw.y = pk2(vs[2], vs[3]); pw.z = pk2(vs[4], vs[5]); pw.w = pk2(vs[6], vs[7]); *(LAS u32x4*)(lds + RC_VT + pt * MP + c8 * 2) = pw;
            if (tid >= NTHREADS - 64) { const int c = tid - (NTHREADS - 64);
                const float mm = *(LAS const float*)(lds + RC_LW + 31 * FP + c * 4), cl = *(LAS const float*)(lds + RC_LW + 63 * FP + c * 4);
                *(LAS float*)(lds + RC_VEC + c * 4) = __expf(mm); *(LAS float*)(lds + RC_VEC + 256 + c * 4) = __expf(cl); *(LAS float*)(lds + RC_VEC + 512 + c * 4) = __expf(cl - mm); }
        }
        LDS_BARRIER();
        if (pr + pstep < 128) RA_FETCH_Z(pr + pstep, rc, kc, vc, rp, kq, vp);
        f32x16 macc = zero16();
        if (w < 4) { f32x16 acc = zero16(); mm_acc<false, false>(acc, lds + RC_AT, lds + RC_BT, rb, cb, lane); mask_tril<false>(acc, rb, cb, lane);
            st_tile_bf16(lds + RC_XA, acc, rb, cb, lane);
            const int row = 32 * rb + (lane & 31);
#pragma unroll
            for (int j = 0; j < 16; ++j) { const int col = 32 * cb + (j & 3) + 8 * (j >> 2) + 4 * (lane >> 5); macc[j] = acc[j] + (col == row ? 1.0f : 0.0f); }
            st_tile_bf16(lds + RC_TA, macc, rb, cb, lane);
        } else { f32x16 acc = zero16(); mm_acc<false, false>(acc, lds + RC_AT, lds + RC_KT, rb, cb, lane); mask_tril<false>(acc, rb, cb, lane); st_tile_bf16(lds + RC_MAK, acc, rb, cb, lane); }
        LDS_BARRIER();
        if (w < 4) { f32x16 acc = zero16(); mm_acc<false, true>(acc, lds + RC_XA, lds + RC_XA, rb, cb, lane); st_tile_bf16(lds + RC_XB, acc, rb, cb, lane); }
        else { f32x16 acc = zero16(); mm_acc<false, false>(acc, lds + RC_RT, lds + RC_BT, rb, cb, lane); mask_tril<true>(acc, rb, cb, lane); st_tile_bf16(lds + RC_NRB, acc, rb, cb, lane); }
        LDS_BARRIER();
        if (w < 4) { mm_acc<false, true>(macc, lds + RC_TA, lds + RC_XB, rb, cb, lane); st_tile_bf16(lds + RC_TB, macc, rb, cb, lane); }
        else { f32x16 acc = zero16(); mm_acc<false, true>(acc, lds + RC_XB, lds + RC_XB, rb, cb, lane); st_tile_bf16(lds + RC_XA, acc, rb, cb, lane); }
        LDS_BARRIER();
        if (w < 4) { mm_acc<false, true>(macc, lds + RC_TB, lds + RC_XA, rb, cb, lane); st_tile_bf16(lds + RC_TA, macc, rb, cb, lane); }
        else { f32x16 acc = zero16(); mm_acc<false, true>(acc, lds + RC_XA, lds + RC_XA, rb, cb, lane); st_tile_bf16(lds + RC_XB, acc, rb, cb, lane); }
        LDS_BARRIER();
        if (w < 4) { mm_acc<false, true>(macc, lds + RC_TA, lds + RC_XB, rb, cb, lane); st_tile_bf16(lds + RC_TB, macc, rb, cb, lane); }
        else { f32x16 acc = zero16(); mm_acc<false, true>(acc, lds + RC_XB, lds + RC_XB, rb, cb, lane); st_tile_bf16(lds + RC_XA, acc, rb, cb, lane); }
        LDS_BARRIER();
        if (w < 4) { mm_acc<false, true>(macc, lds + RC_TB, lds + RC_XA, rb, cb, lane); st_tile_bf16(lds + RC_TA, macc, rb, cb, lane); }
        else { f32x16 acc = zero16(); mm_acc<false, true>(acc, lds + RC_XA, lds + RC_XA, rb, cb, lane); st_tile_bf16(lds + RC_XB, acc, rb, cb, lane); }
        LDS_BARRIER();
        if (w < 4) { mm_acc<false, true>(macc, lds + RC_TA, lds + RC_XB, rb, cb, lane); st_tile_bf16(lds + RC_TB, macc, rb, cb, lane); }
        else { f32x16 acc = zero16(); mm_acc<false, false>(acc, lds + RC_RT, lds + RC_KT, rb, cb, lane); mask_tril<true>(acc, rb, cb, lane); st_tile_bf16(lds + RC_NRK, acc, rb, cb, lane);
            acc = zero16(); mm_acc<false, true>(acc, lds + RC_MAK, lds + RC_VT, rb, cb, lane); st_tile_bf16(lds + RC_XA, acc, rb, cb, lane); }
        LDS_BARRIER();
        if (w < 4) { f32x16 acc = zero16(); mm_acc<false, true>(acc, lds + RC_TB, lds + RC_AT, rb, cb, lane);
#pragma unroll
            for (int j = 0; j < 16; ++j) acc[j] *= *(LAS float*)(lds + RC_VEC + (32 * cb + (j & 3) + 8 * (j >> 2) + 4 * (lane >> 5)) * 4);
            st_tile_bf16(lds + RC_XB, acc, rb, cb, lane); }
        else { f32x16 acc = zero16(); mm_acc<false, true>(acc, lds + RC_TB, lds + RC_XA, rb, cb, lane); st_tile_bf16(lds + RC_TA, acc, rb, cb, lane); }
        LDS_BARRIER();
        if (w < 4) { f32x16 acc = zero16(); mm_acc<false, true>(acc, lds + RC_NRB, lds + RC_XB, rb, cb, lane);
            { LAS const unsigned char* rrow = lds + RC_RT + (32 * rb + (lane & 31)) * MP + (32 * cb + 4 * (lane >> 5)) * 2;
#pragma unroll
              for (int g = 0; g < 4; ++g) { const u32x2 rw = *(LAS const u32x2*)(rrow + 16 * g); const f32x4 em = *(LAS f32x4*)(lds + RC_VEC + (32 * cb + 4 * (lane >> 5) + 8 * g) * 4);
                  acc[4 * g] += bflo(rw.x) * em[0]; acc[4 * g + 1] += bfhi(rw.x) * em[1]; acc[4 * g + 2] += bflo(rw.y) * em[2]; acc[4 * g + 3] += bfhi(rw.y) * em[3]; } }
            st_tile_bf16(lds + RC_XA, acc, rb, cb, lane);
            acc = zero16(); mm_acc<false, true>(acc, lds + RC_NRB, lds + RC_TA, rb, cb, lane); mm_acc<false, true>(acc, lds + RC_NRK, lds + RC_VT, rb, cb, lane);
            st_tile_bf16(lds + RC_TB, acc, rb, cb, lane); }
        else { const int krow = 32 * rb + (lane & 31);
            const float ecl = *(LAS float*)(lds + RC_VEC + 256 + krow * 4), eclm = *(LAS float*)(lds + RC_VEC + 512 + krow * 4);
            f32x16 acc = zero16(); mm_acc<true, true>(acc, lds + RC_BT, lds + RC_XB, rb, cb, lane);
#pragma unroll
            for (int j = 0; j < 16; ++j) { const int col = 32 * cb + (j & 3) + 8 * (j >> 2) + 4 * (lane >> 5); acc[j] = eclm * acc[j] + (col == krow ? ecl : 0.0f); }
            st_tile_bf16(lds + RC_MAK, acc, rb, cb, lane);
            acc = zero16(); mm_acc<true, true>(acc, lds + RC_BT, lds + RC_TA, rb, cb, lane); mm_acc<true, true>(acc, lds + RC_KT, lds + RC_VT, rb, cb, lane);
#pragma unroll
            for (int j = 0; j < 16; ++j) acc[j] *= eclm;
            st_tile_bf16(lds + RC_S0, acc, rb, cb, lane); }
        LDS_BARRIER();
        {
            const u32x4 o0 = *(LAS u32x4*)(lds + RC_XA + pt * MP + c8 * 2), o1 = *(LAS u32x4*)(lds + RC_TB + pt * MP + c8 * 2), o2 = *(LAS u32x4*)(lds + RC_MAK + pt * MP + c8 * 2), o3 = *(LAS u32x4*)(lds + RC_S0 + pt * MP + c8 * 2);
            *(u32x4*)((bf16*)(ws + WS_RWR) + unit * 4096 + pt * 64 + c8) = o0;
            *(u32x4*)((bf16*)(ws + WS_ZSM + ((size_t)b * T + (size_t)ck * 64 + pt) * 4096 + YLOC_OFF(h)) + c8) = o1;
            *(u32x4*)((bf16*)(ws + WS_RG) + unit * 4096 + pt * 64 + c8) = o2;
            *(u32x4*)((bf16*)(ws + WS_RSL) + unit * 4096 + pt * 64 + c8) = o3; }
        LDS_BARRIER();
    }
#undef RA_FETCH_Z
#undef RA_FETCH_W
}

constexpr int RB_GM = 0, RB_WR = 9216, RB_SB = 18432, RB_YF = 27648, RB_YF2 = 45056;
__device__ __forceinline__ void rwkvB_unit(const Args& a, LAS unsigned char* lds, int b, int h) {
    const int tid = threadIdx.x, lane = tid & 63, w = __builtin_amdgcn_readfirstlane(tid >> 6);
    unsigned char* ws = a.ws;
    const bf16* zrkv = (const bf16*)(ws + WS_ZRKV); const bf16* gates = (const bf16*)(ws + WS_GATES); bf16* mixed = (bf16*)(ws + WS_XN);
    const bf16* Gg = (const bf16*)(ws + WS_RG); const bf16* SLg = (const bf16*)(ws + WS_RSL); const bf16* WRg = (const bf16*)(ws + WS_RWR); const float* BCg = (const float*)(ws + WS_RBC);
    const int pt = tid >> 3, c8 = (tid & 7) * 8, ch = h * 64 + c8;
    if (tid < 64) { LAS float* cst = (LAS float*)(lds + RC_CST); const int hc = h * 64 + tid; cst[2 * 64 + tid] = a.in[I_MU][2048 + hc]; cst[10 * 64 + tid] = a.in[I_LNG][hc]; cst[11 * 64 + tid] = a.in[I_LNB][hc]; }
    const int wq = w & 3, rb = wq >> 1, cb = wq & 1;
    const size_t u0 = ((size_t)(b * 16 + h)) * 64;
    { const f32x16 z = zero16(); if (w >= 4) st_tile_bf16(lds + RB_SB, z, rb, cb, lane); }
#define RB_FETCH(ck_, gp_, wp_, loc_, vc_, vp_, g4_, bc_) do { const size_t un_ = u0 + (ck_); const int tp_ = (ck_) * 64 + pt; const size_t tk_ = (size_t)b * T + tp_; \
        gp_ = *(const u32x4*)(Gg + un_ * 4096 + pt * 64 + c8); wp_ = *(const u32x4*)(WRg + un_ * 4096 + pt * 64 + c8); \
        loc_ = (w < 4) ? ld_tile_bf16_g((const bf16*)(ws + WS_ZSM + ((size_t)b * T + (size_t)(ck_) * 64) * 4096 + YLOC_OFF(h)), 2048, rb, cb, lane) : ld_tile_bf16_g(SLg + un_ * 4096, 64, rb, cb, lane); \
        const bf16* zr_ = zrkv + tk_ * 3072 + 2048 + ch; vc_ = *(const u32x4*)(zr_); vp_ = (u32x4){0u, 0u, 0u, 0u}; if (tp_ > 0) vp_ = *(const u32x4*)(zr_ - 3072); \
        g4_ = *(const u32x4*)(gates + tk_ * 2048 + ch); bc_ = BCg[un_ * 64 + pt]; } while (0)
    u32x4 gp, wp, vc, vp, g4; f32x16 loc; float bc;
    u32x4 vcq = (u32x4){0u, 0u, 0u, 0u}, vpq = vcq, g4q = vcq; float bcq = 0.f;
#define RB_NORM(YFq, ckq) do { const size_t tok = (size_t)b * T + (size_t)(ckq) * 64 + pt; \
            const f32x4 y0 = *(LAS f32x4*)((YFq) + pt * FP + c8 * 4), y1 = *(LAS f32x4*)((YFq) + pt * FP + c8 * 4 + 16); \
            float yv[8]; \
            _Pragma("unroll") for (int j = 0; j < 8; ++j) yv[j] = j < 4 ? y0[j & 3] : y1[j & 3]; \
            float sm = 0.f; \
            _Pragma("unroll") for (int j = 0; j < 8; ++j) sm += yv[j]; \
            const float mean = allsum8(sm) * (1.0f / 64.0f); float sq = 0.f; \
            _Pragma("unroll") for (int j = 0; j < 8; ++j) { yv[j] -= mean; sq += yv[j] * yv[j]; } \
            const float rstd = rsqrtf(allsum8(sq) * (1.0f / 64.0f) + 64e-5f); \
            float o[8]; \
            CSTV(mu_v, 2) CSTV(ln_g, 10) CSTV(ln_b, 11) \
            _Pragma("unroll") for (int j = 0; j < 4; ++j) { const unsigned gw = j == 0 ? g4q.x : j == 1 ? g4q.y : j == 2 ? g4q.z : g4q.w; \
                const unsigned vw = j == 0 ? vcq.x : j == 1 ? vcq.y : j == 2 ? vcq.z : vcq.w, vpw = j == 0 ? vpq.x : j == 1 ? vpq.y : j == 2 ? vpq.z : vpq.w; \
                const float v0 = bflo(vw) + mu_v[2 * j] * (bflo(vpw) - bflo(vw)), v1 = bfhi(vw) + mu_v[2 * j + 1] * (bfhi(vpw) - bfhi(vw)); \
                o[2 * j] = (yv[2 * j] * rstd * ln_g[2 * j] + ln_b[2 * j] + bcq * v0) * bflo(gw); \
                o[2 * j + 1] = (yv[2 * j + 1] * rstd * ln_g[2 * j + 1] + ln_b[2 * j + 1] + bcq * v1) * bfhi(gw); } \
            u32x4 ow; ow.x = pk2(o[0], o[1]); ow.y = pk2(o[2], o[3]); ow.z = pk2(o[4], o[5]); ow.w = pk2(o[6], o[7]); \
            *(u32x4*)(mixed + tok * 2048 + ch) = ow; } while (0)
    RB_FETCH(0, gp, wp, loc, vc, vp, g4, bc);
    for (int ck = 0; ck < T / 64; ++ck) {
        LAS unsigned char* YFc = lds + ((ck & 1) ? RB_YF2 : RB_YF); LAS unsigned char* YFp = lds + ((ck & 1) ? RB_YF : RB_YF2);
        *(LAS u32x4*)(lds + RB_GM + pt * MP + c8 * 2) = gp; *(LAS u32x4*)(lds + RB_WR + pt * MP + c8 * 2) = wp;
        u32x4 gpn = gp, wpn = wp, vcn = vc, vpn = vp, g4n = g4; f32x16 locn = loc; float bcn = bc;
        if (ck + 1 < T / 64) RB_FETCH(ck + 1, gpn, wpn, locn, vcn, vpn, g4n, bcn);
        LDS_BARRIER();
        if (w < 4) mm_acc<false, true>(loc, lds + RB_WR, lds + RB_SB, rb, cb, lane);
        else       mm_acc<false, true>(loc, lds + RB_GM, lds + RB_SB, rb, cb, lane);
        if (ck > 0) RB_NORM(YFp, ck - 1);
        if (w < 4) st_tile_f32(YFc, loc, rb, cb, lane);
        LDS_BARRIER();
        if (w >= 4) st_tile_bf16(lds + RB_SB, loc, rb, cb, lane);
        vcq = vc; vpq = vp; g4q = g4; bcq = bc;
        gp = gpn; wp = wpn; vc = vcn; vp = vpn; g4 = g4n; loc = locn; bc = bcn;
    }
    RB_NORM(lds + (((T / 64 - 1) & 1) ? RB_YF2 : RB_YF), T / 64 - 1);
    LDS_BARRIER();
#undef RB_NORM
#undef RB_FETCH
}

constexpr int CS_PITCH = 560, PB_PITCH = 80;
constexpr int DSA_WSLAB = 32 * CS_PITCH + 16 * PB_PITCH + 64;
__device__ __forceinline__ unsigned fkey(float x) { const unsigned u = __builtin_bit_cast(unsigned, x); return u ^ ((unsigned)((int)u >> 31) | 0x80000000u); }
__device__ __forceinline__ int mbcnt64(unsigned long long m) { return __builtin_amdgcn_mbcnt_hi((unsigned)(m >> 32), __builtin_amdgcn_mbcnt_lo((unsigned)m, 0u)); }
__device__ __forceinline__ int t5_bucket(int rel) {
    const int n = rel < 0 ? -rel : rel; int r = rel > 0 ? 16 : 0;
    if (n < 8) return r + n;
    int large = 2 + (31 - __clz(n * n)); if (large > 15) large = 15;
    return r + large;
}
__device__ __forceinline__ void dsa_scores4(const Args& a, LAS float* SC, LAS const unsigned char* QI, LAS const float* WI, int b, int q0, int L, int xw, int lane) {
    unsigned char* ws = a.ws;
    const bf16* qidx = (const bf16*)(ws + WS_QIDX); const bf16* kidx = (const bf16*)(ws + WS_KIDX); const float* widx = (const float*)(ws + WS_WIDX);
    const size_t tok0 = (size_t)b * T + q0, kb = (size_t)b * T;
    if (L > 256) {
        const int i = lane & 31, half = lane >> 5, head = (i & 3) | ((i >> 3) << 2), qsub = (i >> 2) & 1;
        bf16x8 af[2][4]; float wq[2][16];
#pragma unroll
        for (int rbk = 0; rbk < 2; ++rbk) {
#pragma unroll
            for (int ks = 0; ks < 4; ++ks) af[rbk][ks] = *(LAS const bf16x8*)(QI + (rbk * 32 + i) * 144 + ks * 32 + half * 16);
#pragma unroll
            for (int j = 0; j < 4; ++j) { const f32x4 v = *(LAS const f32x4*)(WI + (2 * rbk + half) * 16 + j * 4); wq[rbk][j * 4 + 0] = v[0]; wq[rbk][j * 4 + 1] = v[1]; wq[rbk][j * 4 + 2] = v[2]; wq[rbk][j * 4 + 3] = v[3]; }
        }
        const int ntiles = L / 32; const bf16* kp0 = kidx + (kb >> 5) * 2048 + lane * 8;
        bf16x8 B[4][4];
#pragma unroll
        for (int j = 0; j < 4; ++j) { const int t0 = (xw + 4 * j < ntiles) ? xw + 4 * j : xw;
#pragma unroll
            for (int ks = 0; ks < 4; ++ks) B[j][ks] = *(const bf16x8*)(kp0 + (size_t)t0 * 2048 + ks * 512); }
#define DSA_MM(acc_, rbk_, j_) do { _Pragma("unroll") for (int jj = 0; jj < 16; ++jj) acc_[jj] = 0.f; \
                _Pragma("unroll") for (int ks = 0; ks < 4; ++ks) acc_ = __builtin_amdgcn_mfma_f32_32x32x16_bf16(af[rbk_][ks], B[j_][ks], acc_, 0, 0, 0); } while (0)
#define DSA_EPI(acc_, rbk_) do { f32x2_t sc2_ = {0.f, 0.f}; \
                _Pragma("unroll") for (int jj = 0; jj < 16; jj += 2) { int x0_ = __float_as_int(acc_[jj]), x1_ = __float_as_int(acc_[jj + 1]); x0_ = x0_ > 0 ? x0_ : 0; x1_ = x1_ > 0 ? x1_ : 0; \
                    const f32x2_t r2_ = {__int_as_float(x0_), __int_as_float(x1_)}; const f32x2_t w2_ = {wq[rbk_][jj], wq[rbk_][jj + 1]}; sc2_ = __builtin_elementwise_fma(w2_, r2_, sc2_); } \
                SC[(2 * (rbk_) + half) * 4096 + kt * 32 + i] = sc2_.x + sc2_.y; } while (0)
        int kt0 = xw;
        for (; kt0 + 12 < ntiles; kt0 += 16) {
#pragma unroll
            for (int j = 0; j < 4; ++j) { const int kt = kt0 + 4 * j; f32x16 accA, accB;
                DSA_MM(accA, 0, j); DSA_MM(accB, 1, j);
                { float a0_ = accA[0], b0_ = accB[0]; asm volatile("" : "+v"(a0_), "+v"(b0_)); accA[0] = a0_; accB[0] = b0_; }
                { const int tn = (kt + 16 < ntiles) ? kt + 16 : kt;
#pragma unroll
                  for (int ks = 0; ks < 4; ++ks) B[j][ks] = *(const bf16x8*)(kp0 + (size_t)tn * 2048 + ks * 512); }
                DSA_EPI(accA, 0); DSA_EPI(accB, 1); }
        }
#pragma unroll
        for (int j = 0; j < 4; ++j) { const int kt = kt0 + 4 * j;
            if (kt < ntiles) { f32x16 accA, accB;
                DSA_MM(accA, 0, j); DSA_MM(accB, 1, j);
                { float a0_ = accA[0], b0_ = accB[0]; asm volatile("" : "+v"(a0_), "+v"(b0_)); accA[0] = a0_; accB[0] = b0_; }
                DSA_EPI(accA, 0); DSA_EPI(accB, 1); } }
#undef DSA_MM
#undef DSA_EPI
    }
}

template <class F> __device__ __forceinline__ void dsa_select(LAS const float* SCrow, LAS unsigned short* SELr, int L, int lane, F after_load) {
    if (L <= 256) {
        after_load();
        for (int j = lane; j < 256; j += 64) SELr[j] = (unsigned short)j;
    } else {
        const int nreg = L / 64; unsigned u[64];
        {
            float xs[64];
#pragma unroll
            for (int g = 0; g < 4; ++g) if (g * 16 < nreg) {
#pragma unroll
                for (int j = 16 * g; j < 16 * g + 16; ++j) xs[j] = SCrow[j * 64 + lane]; }
#pragma unroll
            for (int g = 0; g < 4; ++g) {
                if (g * 16 < nreg) {
#pragma unroll
                    for (int j = 16 * g; j < 16 * g + 16; ++j) u[j] = (j < nreg) ? fkey(xs[j]) : 0u;
                } else {
#pragma unroll
                    for (int j = 16 * g; j < 16 * g + 16; ++j) u[j] = 0u; } }
        }
        after_load();
#define DSA_CNT4(acc_, c_, k0_) do { unsigned long long m0_, m1_, m2_, m3_; \
            asm volatile("v_cmp_le_u32_e64 %1, %5, %6\n\tv_cmp_le_u32_e64 %2, %5, %7\n\tv_cmp_le_u32_e64 %3, %5, %8\n\tv_cmp_le_u32_e64 %4, %5, %9\n\t" \
                         "v_addc_co_u32_e64 %0, %1, 0, %0, %1\n\tv_addc_co_u32_e64 %0, %2, 0, %0, %2\n\tv_addc_co_u32_e64 %0, %3, 0, %0, %3\n\tv_addc_co_u32_e64 %0, %4, 0, %0, %4" \
                         : "+v"(acc_), "=&s"(m0_), "=&s"(m1_), "=&s"(m2_), "=&s"(m3_) : "s"(c_), "v"(u[(k0_)]), "v"(u[(k0_) + 1]), "v"(u[(k0_) + 2]), "v"(u[(k0_) + 3])); } while (0)
#define DSA_COUNT(NG_, c_, cnt_) do { int c0_ = 0, c1_ = 0; const unsigned cc_ = __builtin_amdgcn_readfirstlane(c_); \
            _Pragma("unroll") for (int g8 = 0; g8 < (NG_); ++g8) { DSA_CNT4(c0_, cc_, g8 * 8); DSA_CNT4(c1_, cc_, g8 * 8 + 4); } \
            int cl_ = c0_ + c1_; \
            cl_ += __builtin_amdgcn_update_dpp(0, cl_, 0xB1, 0xF, 0xF, true); cl_ += __builtin_amdgcn_update_dpp(0, cl_, 0x4E, 0xF, 0xF, true); \
            cl_ += __builtin_amdgcn_update_dpp(0, cl_, 0x141, 0xF, 0xF, true); cl_ += __builtin_amdgcn_update_dpp(0, cl_, 0x140, 0xF, 0xF, true); \
            cnt_ = __builtin_amdgcn_readlane(cl_, 0) + __builtin_amdgcn_readlane(cl_, 16) + __builtin_amdgcn_readlane(cl_, 32) + __builtin_amdgcn_readlane(cl_, 48); } while (0)
        unsigned umax = 0u;
#pragma unroll
        for (int g8 = 0; g8 < 8; ++g8) if (g8 * 8 < nreg) {
#pragma unroll
            for (int j = 8 * g8; j < 8 * g8 + 8; ++j) umax = umax > u[j] ? umax : u[j]; }
        { int m = (int)umax; m = max(m ^ 0x80000000, __builtin_amdgcn_update_dpp(0, m ^ 0x80000000, 0xB1, 0xF, 0xF, true)); m = max(m, __builtin_amdgcn_update_dpp(0, m, 0x4E, 0xF, 0xF, true));
          m = max(m, __builtin_amdgcn_update_dpp(0, m, 0x141, 0xF, 0xF, true)); m = max(m, __builtin_amdgcn_update_dpp(0, m, 0x140, 0xF, 0xF, true));
          m = max(max(__builtin_amdgcn_readlane(m, 0), __builtin_amdgcn_readlane(m, 16)), max(__builtin_amdgcn_readlane(m, 32), __builtin_amdgcn_readlane(m, 48))); umax = (unsigned)m ^ 0x80000000u; }
        unsigned lo = 1u, hi = umax + 1u, thr = 0u; bool exact = false;
#define DSA_SEARCH(NG_) do { unsigned c = umax & 0xFF800000u; int cnt;          \
            for (int step = 0; step < 6; ++step) { if (c <= 1u) break; DSA_COUNT(NG_, c, cnt); if (cnt == 256) { thr = c; exact = true; break; } if (cnt > 256) { lo = c; break; } hi = c; if (c < 0x00800000u + 1u) break; c -= 0x00800000u; } \
            while (!exact && hi - lo > 1u) { const unsigned mid = lo + ((hi - lo) >> 1); DSA_COUNT(NG_, mid, cnt); if (cnt == 256) { thr = mid; exact = true; } else if (cnt > 256) lo = mid; else hi = mid; } \
            if (!exact) thr = lo;              \
        } while (0)
        switch ((nreg + 7) >> 3) { case 1: DSA_SEARCH(1); break; case 2: DSA_SEARCH(2); break; case 3: DSA_SEARCH(3); break; case 4: DSA_SEARCH(4); break;
                                   case 5: DSA_SEARCH(5); break; case 6: DSA_SEARCH(6); break; case 7: DSA_SEARCH(7); break; default: DSA_SEARCH(8); break; }
#undef DSA_SEARCH
        if (exact) {
            int cl = 0; { int c1 = 0; const unsigned tt = __builtin_amdgcn_readfirstlane(thr);
#pragma unroll
                for (int g8 = 0; g8 < 8; ++g8) if (g8 * 8 < nreg) { DSA_CNT4(cl, tt, g8 * 8); DSA_CNT4(c1, tt, g8 * 8 + 4); }
                cl += c1; }
            int x = cl;
            x += __builtin_amdgcn_update_dpp(0, x, 0x111, 0xF, 0xF, true); x += __builtin_amdgcn_update_dpp(0, x, 0x112, 0xF, 0xF, true);
            x += __builtin_amdgcn_update_dpp(0, x, 0x114, 0xF, 0xF, true); x += __builtin_amdgcn_update_dpp(0, x, 0x118, 0xF, 0xF, true);
            x += __builtin_amdgcn_update_dpp(0, x, 0x142, 0xA, 0xF, false);
            x += __builtin_amdgcn_update_dpp(0, x, 0x143, 0xC, 0xF, false);
            int off = x - cl;
#pragma unroll
            for (int g8 = 0; g8 < 8; ++g8) if (g8 * 8 < nreg) {
#pragma unroll
                for (int j = 8 * g8; j < 8 * g8 + 8; ++j) { if (u[j] >= thr) { SELr[off] = (unsigned short)(j * 64 + lane); ++off; } } }
        } else {
            int ngt = 0;
#pragma unroll
            for (int j = 0; j < 64; ++j) if (j < nreg) ngt += __popcll(__ballot(u[j] > thr));
            int ties_left = 256 - ngt, pos = 0;
#pragma unroll
            for (int j = 0; j < 64; ++j) if (j < nreg) {
                const bool gt = u[j] > thr, eq = u[j] == thr;
                const unsigned long long em = __ballot(eq);
                const bool take = gt || (eq && mbcnt64(em) < ties_left);
                const unsigned long long tm = __ballot(take);
                if (take) SELr[pos + mbcnt64(tm)] = (unsigned short)(j * 64 + lane);
                pos += __popcll(tm); const int ne = __popcll(em); ties_left -= (ne < ties_left ? ne : ties_left);
            }
        }
#undef DSA_COUNT
#undef DSA_CNT4
    }
}

__device__ __forceinline__ void dsa_attend(const Args& a, LAS unsigned char* CSw, LAS const unsigned short* SELr, LAS const float* BIAS, int b, int qpos, int nk, int lane) {
    unsigned char* ws = a.ws; const bf16* ckv = (const bf16*)(ws + WS_CKV); bf16* qabs = (bf16*)a.out;
    {
        const int fr = lane & 15, hq = lane >> 4, g = lane >> 4, qq = (lane & 15) >> 2, pp = lane & 3;
        LAS unsigned char* PBw = CSw + 32 * CS_PITCH; LAS float* MSw = (LAS float*)(PBw + 16 * PB_PITCH);
        const size_t tok = (size_t)b * T + qpos, kb = (size_t)b * T;
        const int nch = nk / 32;
        float rinvq; { const float* qs = (const float*)(ws + WS_QSS) + tok * 8; const f32x4 s0 = *(const f32x4*)qs, s1 = *(const f32x4*)(qs + 4);
            rinvq = 1.44269504088896341f * rsqrtf(((s0[0] + s0[1]) + (s0[2] + s0[3]) + (s1[0] + s1[1]) + (s1[2] + s1[3])) * (1.0f / 384.0f) + 1e-6f); }
        bf16x8 gl[16], aq[8];
#define DSA_LOAD_CH(c_) do { \
        _Pragma("unroll") for (int i_ = 0; i_ < 16; ++i_) { const int idx = SELr[32 * (c_) + (i_ >> 2) * 8 + (lane >> 3)]; \
            gl[i_] = *(const bf16x8*)(ckv + (kb + idx) * KVR + (i_ & 3) * 64 + (lane & 7) * 8); } } while (0)
#pragma unroll
        for (int ks = 0; ks < 8; ++ks) aq[ks] = __builtin_nontemporal_load((const bf16x8*)(qabs + tok * 4096 + fr * 256 + ks * 32 + hq * 8));
        DSA_LOAD_CH(0);
        f32x4 oacc[16];
#pragma unroll
        for (int nt = 0; nt < 16; ++nt) oacc[nt] = (f32x4){0.f, 0.f, 0.f, 0.f};
        float mref[4] = {0.f, 0.f, 0.f, 0.f}, lsum[4] = {0.f, 0.f, 0.f, 0.f};
        for (int c = 0; c < nch; ++c) {
#pragma unroll
            for (int i_ = 0; i_ < 16; ++i_) *(LAS bf16x8*)(CSw + ((i_ >> 2) * 8 + (lane >> 3)) * CS_PITCH + (i_ & 3) * 128 + (lane & 7) * 16) = gl[i_];
            if (c + 1 < nch) DSA_LOAD_CH(c + 1);
            f32x4 sv[2];
#pragma unroll
            for (int j = 0; j < 2; ++j) { f32x4 acc = (f32x4){0.f, 0.f, 0.f, 0.f};
#pragma unroll
                for (int ks = 0; ks < 8; ++ks) { const bf16x8 bfr = *(LAS bf16x8*)(CSw + (16 * j + fr) * CS_PITCH + (ks * 32 + hq * 8) * 2); acc = __builtin_amdgcn_mfma_f32_16x16x32_bf16(aq[ks], bfr, acc, 0, 0, 0); }
                const int kidxv = SELr[32 * c + 16 * j + fr]; const int bk = t5_bucket(kidxv - qpos);
                sv[j] = acc * rinvq + *(LAS f32x4*)(BIAS + bk * 16 + hq * 4); }
            if (c == 0) {
#pragma unroll
                for (int r = 0; r < 4; ++r) mref[r] = allmax16(fmaxf(sv[0][r], sv[1][r]));
            }
#pragma unroll
            for (int r = 0; r < 4; ++r) { const float p0 = __builtin_amdgcn_exp2f(sv[0][r] - mref[r]), p1 = __builtin_amdgcn_exp2f(sv[1][r] - mref[r]); lsum[r] += p0 + p1;
                const unsigned pw = pk2(p0, p1);
                *(LAS unsigned short*)(PBw + (hq * 4 + r) * PB_PITCH + fr * 2) = (unsigned short)pw;
                *(LAS unsigned short*)(PBw + (hq * 4 + r) * PB_PITCH + (16 + fr) * 2) = (unsigned short)(pw >> 16); }
            asm volatile("s_waitcnt lgkmcnt(0)" ::: "memory");
            const bf16x8 pa = *(LAS bf16x8*)(PBw + fr * PB_PITCH + hq * 16);
            LAS unsigned char* base = CSw + (8 * g + qq) * CS_PITCH + (4 * pp) * 2;
#pragma unroll
            for (int nt = 0; nt < 16; ++nt) {
                const s16x4 b0 = __builtin_amdgcn_ds_read_tr16_b64_v4i16((LAS s16x4*)(base + nt * 32));
                const s16x4 b1 = __builtin_amdgcn_ds_read_tr16_b64_v4i16((LAS s16x4*)(base + nt * 32 + 4 * CS_PITCH));
                const bf16x8 bf = (bf16x8){b0[0], b0[1], b0[2], b0[3], b1[0], b1[1], b1[2], b1[3]};
                oacc[nt] = __builtin_amdgcn_mfma_f32_16x16x32_bf16(bf, pa, oacc[nt], 0, 0, 0);
            }
            asm volatile("s_waitcnt lgkmcnt(0)" ::: "memory");
        }
#pragma unroll
        for (int r = 0; r < 4; ++r) { const float ps = allsum16(lsum[r]); if (fr == 0) MSw[hq * 4 + r] = ps; }
        asm volatile("s_waitcnt lgkmcnt(0)" ::: "memory");
        const float inv = __builtin_amdgcn_rcpf(MSw[fr]);
#pragma unroll
        for (int nt = 0; nt < 16; ++nt) { int w8 = __builtin_amdgcn_cvt_pk_fp8_f32(oacc[nt][0] * inv, oacc[nt][1] * inv, 0, false); w8 = __builtin_amdgcn_cvt_pk_fp8_f32(oacc[nt][2] * inv, oacc[nt][3] * inv, w8, true);
            *(LAS int*)(CSw + fr * 272 + nt * 16 + hq * 4) = w8; }
        asm volatile("s_waitcnt lgkmcnt(0)" ::: "memory");
        unsigned char* op = (unsigned char*)(qabs + tok * 4096) + lane * 16;
#pragma unroll
        for (int it = 0; it < 4; ++it) { const u32x4 ov = *(LAS u32x4*)(CSw + (4 * it + (lane >> 4)) * 272 + (lane & 15) * 16); __builtin_nontemporal_store(ov, (u32x4*)(op + it * 1024)); }
        asm volatile("s_waitcnt lgkmcnt(0)" ::: "memory");
#undef DSA_LOAD_CH
    }
}

constexpr int DP_SC = 0, DP_SLAB = 65536, DP_SEL = DP_SLAB + 4 * DSA_WSLAB, DP_BIAS = DP_SEL + 4096, DP_FLG = DP_BIAS + 2048, DP_QI = DP_FLG + 256, DP_WI = DP_QI + 64 * 144;
static_assert(DP_SLAB >= 4 * 4096 * 4 && DP_WI + 256 <= LDS_BYTES - 256, "pipelined DSA LDS map");
__device__ __forceinline__ void lds_sig_add(volatile LAS int* p, int lane) { asm volatile("s_waitcnt lgkmcnt(0)" ::: "memory"); if (lane == 0) (void)__hip_atomic_fetch_add((LAS int*)p, 1, __ATOMIC_RELAXED, __HIP_MEMORY_SCOPE_WORKGROUP); }
__device__ __forceinline__ void lds_sig_set(volatile LAS int* p, int v, int lane) { asm volatile("s_waitcnt lgkmcnt(0)" ::: "memory"); if (lane == 0) *p = v; }
__device__ __forceinline__ void lds_wait_ge(volatile LAS int* p, int v) { while (__builtin_amdgcn_readfirstlane(*p) < v) __builtin_amdgcn_s_sleep(1); asm volatile("" ::: "memory"); }
__device__ __forceinline__ void dsa_phase(const Args& a, LAS unsigned char* lds, int bx) {
    const int tid = threadIdx.x, lane = tid & 63, w = __builtin_amdgcn_readfirstlane(tid >> 6);
    unsigned char* ws = a.ws;
    volatile LAS int* FLG = (volatile LAS int*)(lds + DP_FLG);
    LAS float* BIAS = (LAS float*)(lds + DP_BIAS);
    BIAS[tid] = a.in[I_RELB][tid] * 1.44269504088896341f;
    if (tid < 32) FLG[tid] = 0;
    __syncthreads();
    if (w < 4) {
        const int xw = w; int nx = 0, bb = (bx >> 2) & 1, nxt = 0; bool stolen = false;
        __builtin_amdgcn_s_setprio(2);
#define DSA_TICKET() ((int)__hip_atomic_fetch_add((unsigned*)(ws + WS_CTL + CTL_QUEUE + bb * 256), 1u, __ATOMIC_RELAXED, __HIP_MEMORY_SCOPE_AGENT))
#define X_BARRIER() do { ++nx; lds_sig_add(FLG + 8, lane); lds_wait_ge(FLG + 8, 4 * nx); } while (0)
#define DSA_PUBLISH(rr_) do { int u = __builtin_amdgcn_readfirstlane(nxt); \
            while (u >= 1024) { if (stolen) { u = -1; break; } stolen = true; bb ^= 1; int t = 0; if (lane == 0) t = DSA_TICKET(); u = __builtin_amdgcn_readfirstlane(t); } \
            if (lane == 0) { FLG[16 + ((rr_) & 3) * 2] = bb; FLG[17 + ((rr_) & 3) * 2] = (u < 0) ? -1 : 1023 - u; } \
            if (u >= 0 && lane == 0) nxt = DSA_TICKET(); } while (0)
        const bf16* qidxg = (const bf16*)(ws + WS_QIDX); const float* widxg = (const float*)(ws + WS_WIDX);
        LAS unsigned char* QI = lds + DP_QI; LAS float* WI = (LAS float*)(lds + DP_WI);
        u32x4 qv0 = (u32x4){0u, 0u, 0u, 0u}, qv1 = qv0; f32x4 wv4 = (f32x4){0.f, 0.f, 0.f, 0.f};
#define DSA_STAGE_LOAD(b_, q0_) do { const size_t tk_ = (size_t)(b_) * T + (q0_) + xw; qv0 = __builtin_nontemporal_load((const u32x4*)(qidxg + tk_ * 1024 + lane * 8)); qv1 = __builtin_nontemporal_load((const u32x4*)(qidxg + tk_ * 1024 + 512 + lane * 8)); \
            if (lane < 4) wv4 = *(const f32x4*)(widxg + tk_ * 16 + lane * 4); } while (0)
#define DSA_STAGE_STORE() do { const int h0_ = lane >> 3, h1_ = 8 + (lane >> 3), pc_ = lane & 7, tb_ = (xw >> 1) * 32 + ((xw & 1) << 2); \
            *(LAS u32x4*)(QI + (tb_ + ((h0_ & 3) | ((h0_ >> 2) << 3))) * 144 + pc_ * 16) = qv0; *(LAS u32x4*)(QI + (tb_ + ((h1_ & 3) | ((h1_ >> 2) << 3))) * 144 + pc_ * 16) = qv1; \
            if (lane < 4) *(LAS f32x4*)(WI + xw * 16 + lane * 4) = wv4; } while (0)
        if (xw == 0) { if (lane == 0) nxt = DSA_TICKET(); DSA_PUBLISH(0); }
        X_BARRIER();
        { const int b0 = __builtin_amdgcn_readfirstlane(FLG[16]), g0 = __builtin_amdgcn_readfirstlane(FLG[17]); if (g0 >= 0) { DSA_STAGE_LOAD(b0, g0 * 4); DSA_STAGE_STORE(); } }
        ++nx; lds_sig_add(FLG + 8, lane);
        for (int r = 0;; ++r) {
            const int b = __builtin_amdgcn_readfirstlane(FLG[16 + (r & 3) * 2]), qg4 = __builtin_amdgcn_readfirstlane(FLG[17 + (r & 3) * 2]);
            lds_wait_ge(FLG + 8, 4 * nx);
            if (qg4 < 0) { lds_sig_set(FLG + xw, r + 1, lane); break; }
            const int q0 = qg4 * 4, L = ((q0 >> 6) + 1) * 64;
            if (L > 256) dsa_scores4(a, (LAS float*)(lds + DP_SC), QI, WI, b, q0, L, xw, lane);
            if (xw == 0) {
                for (int y = 0; y < 4; ++y) lds_wait_ge(FLG + 4 + y, r - 1);
                DSA_PUBLISH(r + 1);
            }
            X_BARRIER();
            const int bn = __builtin_amdgcn_readfirstlane(FLG[16 + ((r + 1) & 3) * 2]), gn4 = __builtin_amdgcn_readfirstlane(FLG[17 + ((r + 1) & 3) * 2]);
            if (gn4 >= 0) DSA_STAGE_LOAD(bn, gn4 * 4);
            LAS unsigned short* SELr = (LAS unsigned short*)(lds + DP_SEL) + ((r & 1) * 4 + xw) * 256;
            dsa_select((LAS const float*)(lds + DP_SC) + xw * 4096, SELr, L, lane, []() { });
            lds_sig_set(FLG + xw, r + 1, lane);
            if (gn4 >= 0) DSA_STAGE_STORE();
            ++nx; lds_sig_add(FLG + 8, lane);
        }
#undef DSA_STAGE_LOAD
#undef DSA_STAGE_STORE
#undef DSA_PUBLISH
#undef DSA_TICKET
#undef X_BARRIER
        __builtin_amdgcn_s_setprio(0);
    } else {
        const int yw = w - 4;
        for (int r = 0;; ++r) {
            lds_wait_ge(FLG + yw, r + 1);
            const int b = __builtin_amdgcn_readfirstlane(FLG[16 + (r & 3) * 2]), qg4 = __builtin_amdgcn_readfirstlane(FLG[17 + (r & 3) * 2]);
            if (qg4 < 0) break;
            const int q0 = qg4 * 4, L = ((q0 >> 6) + 1) * 64, nk = L < 256 ? L : 256;
            dsa_attend(a, lds + DP_SLAB + yw * DSA_WSLAB, (LAS const unsigned short*)(lds + DP_SEL) + ((r & 1) * 4 + yw) * 256, BIAS, b, q0 + yw, nk, lane);
            lds_sig_set(FLG + 4 + yw, r + 1, lane);
        }
    }
    __syncthreads();
}

__device__ __forceinline__ void uv_phase(const Args& a, LAS unsigned char* lds, int h, int tt0, int tstep) {
    const int tid = threadIdx.x, lane = tid & 63, w = __builtin_amdgcn_readfirstlane(tid >> 6), mt = w & 3, nt = w >> 2, i = lane & 31, half = lane >> 5;
    unsigned char* ws = a.ws; const bf16* ol = (const bf16*)a.out; const bf16* wuvt = (const bf16*)(ws + WS_WUVT); const bf16* gates = (const bf16*)(ws + WS_GATES); bf16* mixed = (bf16*)(ws + WS_XN);
    constexpr int UP = 528; LAS unsigned char* Bs = lds; LAS unsigned char* As = lds + 64 * UP; LAS unsigned char* STs = lds + 64 * UP + 128 * UP;
#pragma unroll
    for (int p = 0; p < 4; ++p) { const int pc = tid + p * NTHREADS, r = pc >> 5, c = pc & 31; *(LAS u32x4*)(Bs + r * UP + c * 16) = *(const u32x4*)(wuvt + (size_t)(h * 64 + r) * KVR + c * 8); }
    u32x4 av[4], an[4]; const unsigned char* ol8 = (const unsigned char*)ol;
#define UV_W8(dst_, w_) do { const f32x2_t lo_ = __builtin_amdgcn_cvt_pk_f32_fp8((int)(w_), false), hi_ = __builtin_amdgcn_cvt_pk_f32_fp8((int)(w_), true); dst_##0 = pk2(lo_.x, lo_.y); dst_##1 = pk2(hi_.x, hi_.y); } while (0)
    if (tt0 < M / 128) {
#pragma unroll
        for (int p = 0; p < 4; ++p) { const int pc = tid + p * NTHREADS; av[p] = __builtin_nontemporal_load((const u32x4*)(ol8 + ((size_t)tt0 * 128 + (pc >> 4)) * 8192 + h * 256 + (pc & 15) * 16)); }
    }
    for (int tt = tt0; tt < M / 128; tt += tstep) {
#pragma unroll
        for (int p = 0; p < 4; ++p) { const int pc = tid + p * NTHREADS; unsigned a0, a1, b0, b1, c0, c1, d0, d1;
            UV_W8(a, av[p].x); UV_W8(b, av[p].y); UV_W8(c, av[p].z); UV_W8(d, av[p].w);
            *(LAS u32x4*)(As + (pc >> 4) * UP + (pc & 15) * 32) = (u32x4){a0, a1, b0, b1}; *(LAS u32x4*)(As + (pc >> 4) * UP + (pc & 15) * 32 + 16) = (u32x4){c0, c1, d0, d1}; }
        const int ttn = tt + tstep;
        if (ttn < M / 128) {
#pragma unroll
            for (int p = 0; p < 4; ++p) { const int pc = tid + p * NTHREADS; an[p] = __builtin_nontemporal_load((const u32x4*)(ol8 + ((size_t)ttn * 128 + (pc >> 4)) * 8192 + h * 256 + (pc & 15) * 16)); }
        }
        LDS_BARRIER();
        f32x16 acc;
#pragma unroll
        for (int j = 0; j < 16; ++j) acc[j] = 0.f;
#pragma unroll
        for (int ks = 0; ks < 16; ++ks) { const bf16x8 bd = *(LAS bf16x8*)(Bs + (nt * 32 + i) * UP + (ks * 16 + half * 8) * 2), at = *(LAS bf16x8*)(As + (mt * 32 + i) * UP + (ks * 16 + half * 8) * 2);
            acc = __builtin_amdgcn_mfma_f32_32x32x16_bf16(bd, at, acc, 0, 0, 0); }
        {   LAS unsigned char* strow = STs + (mt * 32 + i) * FP + (nt * 32 + 4 * half) * 4;
#pragma unroll
            for (int g = 0; g < 4; ++g) *(LAS f32x4*)(strow + 32 * g) = (f32x4){acc[4 * g], acc[4 * g + 1], acc[4 * g + 2], acc[4 * g + 3]}; }
        u32x4 gwv[2];
#pragma unroll
        for (int k = 0; k < 2; ++k) { const int pc = tid + k * NTHREADS; gwv[k] = __builtin_nontemporal_load((const u32x4*)(gates + ((size_t)tt * 128 + (pc >> 3)) * 2048 + 1024 + h * 64 + (pc & 7) * 8)); }
        LDS_BARRIER();
#pragma unroll
        for (int k = 0; k < 2; ++k) { const int pc = tid + k * NTHREADS, tk = pc >> 3, d8 = (pc & 7) * 8;
            const f32x4 y0 = *(LAS f32x4*)(STs + tk * FP + d8 * 4), y1 = *(LAS f32x4*)(STs + tk * FP + d8 * 4 + 16); const u32x4 gw = gwv[k];
            u32x4 ov; ov.x = pk2(y0[0] * bflo(gw.x), y0[1] * bfhi(gw.x)); ov.y = pk2(y0[2] * bflo(gw.y), y0[3] * bfhi(gw.y)); ov.z = pk2(y1[0] * bflo(gw.z), y1[1] * bfhi(gw.z)); ov.w = pk2(y1[2] * bflo(gw.w), y1[3] * bfhi(gw.w));
            *(u32x4*)(mixed + ((size_t)tt * 128 + tk) * 2048 + 1024 + h * 64 + d8) = ov; }
#pragma unroll
        for (int p = 0; p < 4; ++p) av[p] = an[p];
    }
}

__device__ __forceinline__ void phase8(const Args& a) {
    const int tid = threadIdx.x, lane = tid & 63, wave = tid >> 6, G = gridDim.x, bx = blockIdx.x;
    const float* part = (const float*)(a.ws + WS_PART); const float* g = a.in[I_FINALG]; float* out = a.out;
    for (int row = bx * NWAVES + wave; row < M; row += G * NWAVES) {
        float ss = (lane < 32) ? part[(size_t)row * 32 + lane] : 0.f; ss = wave_sum(ss);
        const float r = rsqrtf(ss * (1.0f / D) + 1e-6f); float* orow = out + (size_t)row * D;
#pragma unroll
        for (int i = 0; i < 8; ++i) { const int c = (i * 64 + lane) * 4; f32x4 v = *(const f32x4*)(orow + c); const f32x4 gg = *(const f32x4*)(g + c);
            v[0] = v[0] * r * gg[0]; v[1] = v[1] * r * gg[1]; v[2] = v[2] * r * gg[2]; v[3] = v[3] * r * gg[3]; *(f32x4*)(orow + c) = v; }
    }
}

#define XB_TMO      128
#define XB_XCNT(j)  (256  + 64 * (j))
#define XB_XSUB(j)  (1280 + 64 * (j))
#define XB_XGEN(j)  (2304 + 64 * (j))
#define XB_TOP      3328
#define XB_TOPGEN   3392
#define XCD_BAR_WORDS 3456
#define XB_SPIN_CAP (1u << 18)

__device__ __forceinline__ unsigned xb_ld(unsigned* p)              { return __hip_atomic_load(p, __ATOMIC_RELAXED, __HIP_MEMORY_SCOPE_AGENT); }
__device__ __forceinline__ unsigned xb_add(unsigned* p, unsigned v) { return __hip_atomic_fetch_add(p, v, __ATOMIC_RELAXED, __HIP_MEMORY_SCOPE_AGENT); }
__device__ __forceinline__ unsigned xb_xcc_id() { return (unsigned)__builtin_amdgcn_s_getreg((3 << 11) | 20) & 0xFu; }
#define XB_SPIN(cond, bar) do { unsigned _sp = 0; while (cond) { __builtin_amdgcn_s_sleep(1); \
    if ((++_sp & 255u) == 0u) { if (xb_ld(&(bar)[XB_TMO])) break; if (_sp > XB_SPIN_CAP) { atomicAdd(&(bar)[XB_TMO], 1u); break; } } } } while (0)

struct XcdBarrier {
    unsigned* bar; unsigned x;
    volatile LAS unsigned* st;
};

__device__ __forceinline__ XcdBarrier xcd_barrier_post(unsigned* bar, volatile LAS unsigned* st) {
    XcdBarrier b; b.bar = bar; b.x = xb_xcc_id(); b.st = st;
    if (threadIdx.x == 0) (void)xb_add(&bar[XB_XCNT(b.x)], 1u);
    return b;
}
__device__ __forceinline__ void xcd_barrier_complete(unsigned* bar, unsigned x, unsigned& nloc, unsigned& nx) {
    const unsigned G = gridDim.x * gridDim.y * gridDim.z;
    unsigned sum, cnt, mine, sp = 0u;
    for (;;) {
        sum = 0u; cnt = 0u; mine = 0u;
#pragma unroll
        for (unsigned j = 0; j < 16; ++j) { const unsigned c = xb_ld(&bar[XB_XCNT(j)]); sum += c; cnt += (c > 0u) ? 1u : 0u; mine = (j == x) ? c : mine; }
        if (sum == G) break;
        __builtin_amdgcn_s_sleep(1);
        if ((++sp & 255u) == 0u) { if (xb_ld(&bar[XB_TMO])) break; if (sp > XB_SPIN_CAP) { atomicAdd(&bar[XB_TMO], 1u); break; } }
    }
    nloc = mine > 0u ? mine : 1u; nx = cnt > 0u ? cnt : 1u;
}

__device__ __forceinline__ void xcd_barrier_arrive(const XcdBarrier& b) {
    asm volatile("s_waitcnt vmcnt(0)" ::: "memory");
    __syncthreads();
    if (threadIdx.x == 0) {
        unsigned* bar = b.bar;
        __builtin_amdgcn_s_waitcnt(0);
        unsigned nloc = b.st[0], nx = b.st[1];
        if (nloc == 0u) { xcd_barrier_complete(bar, b.x, nloc, nx); b.st[0] = nloc; b.st[1] = nx; }
        const unsigned old = xb_add(&bar[XB_XSUB(b.x)], 1u);
        const unsigned gen = old / nloc;
        if (old + 1u == (gen + 1u) * nloc) {
            __builtin_amdgcn_fence(__ATOMIC_RELEASE, "agent");
            asm volatile("s_waitcnt vmcnt(0)" ::: "memory");
            const unsigned og = xb_add(&bar[XB_TOP], 1u);
            const unsigned tg = og / nx;
            if (og + 1u == (tg + 1u) * nx) xb_add(&bar[XB_TOPGEN], 1u);
        }
    }
}
__device__ __forceinline__ void xcd_barrier_wait(const XcdBarrier& b) {
    if (threadIdx.x == 0) {
        unsigned* bar = b.bar; const unsigned target = b.st[2] + 1u;
        XB_SPIN((int)(xb_ld(&bar[XB_TOPGEN]) - target) < 0, bar);
        __builtin_amdgcn_fence(__ATOMIC_ACQUIRE, "agent");
        asm volatile("s_waitcnt vmcnt(0)" ::: "memory");
        b.st[2] = target;
    }
    __syncthreads();
}
__device__ __forceinline__ void xcd_barrier(const XcdBarrier& b) { xcd_barrier_arrive(b); xcd_barrier_wait(b); }

struct EpiOutFused {
    static constexpr bool PERM = true, AFTER_DRAIN = true;
    float* out; const pg8::bf16_t* hb; const pg8::bf16_t* ple; float* part; const float* g; const XcdBarrier* bar;
    __device__ __forceinline__ void fused(const pg8::f32x4 (&acc)[2][2][4][2], const pg8::Unit& u, int wr, int wc, int fr, int fq, PG8_LAS unsigned char*, int, int) const {
        using pg8::f32x4; using pg8::u32x4; constexpr int BM = pg8::BM, HALF = pg8::HALF;
        const int row0 = u.pm * BM + wr * 64 + fr, col0 = u.pn * BM + wc * 32 + 8 * fq;
        f32x4 val[2][2][4][2];
#pragma unroll
        for (int ai = 0; ai < 2; ++ai)
#pragma unroll
            for (int m = 0; m < 4; ++m) { const int row = row0 + ai * HALF + m * 16; const size_t ro = (size_t)row * 2048 + col0; float ss = 0.f;
#pragma unroll
                for (int bj = 0; bj < 2; ++bj) { const size_t o = ro + bj * HALF;
                    const u32x4 pw = __builtin_nontemporal_load((const u32x4*)(ple + o)), hw = __builtin_nontemporal_load((const u32x4*)(hb + o));
                    f32x4 p0, p1, v0, v1;
                    p0[0] = __builtin_bit_cast(float, pw.x << 16); p0[1] = __builtin_bit_cast(float, pw.x & 0xffff0000u); p0[2] = __builtin_bit_cast(float, pw.y << 16); p0[3] = __builtin_bit_cast(float, pw.y & 0xffff0000u);
                    p1[0] = __builtin_bit_cast(float, pw.z << 16); p1[1] = __builtin_bit_cast(float, pw.z & 0xffff0000u); p1[2] = __builtin_bit_cast(float, pw.w << 16); p1[3] = __builtin_bit_cast(float, pw.w & 0xffff0000u);
                    v0[0] = __builtin_bit_cast(float, hw.x << 16); v0[1] = __builtin_bit_cast(float, hw.x & 0xffff0000u); v0[2] = __builtin_bit_cast(float, hw.y << 16); v0[3] = __builtin_bit_cast(float, hw.y & 0xffff0000u);
                    v1[0] = __builtin_bit_cast(float, hw.z << 16); v1[1] = __builtin_bit_cast(float, hw.z & 0xffff0000u); v1[2] = __builtin_bit_cast(float, hw.w << 16); v1[3] = __builtin_bit_cast(float, hw.w & 0xffff0000u);
#pragma unroll
                    for (int j = 0; j < 4; ++j) { v0[j] += p0[j] * pg8::sigmoid_f(acc[ai][bj][m][0][j]); v1[j] += p1[j] * pg8::sigmoid_f(acc[ai][bj][m][1][j]); ss += v0[j] * v0[j] + v1[j] * v1[j]; }
                    val[ai][bj][m][0] = v0; val[ai][bj][m][1] = v1; }
                ss = sum_rows4(ss);
                if (fq == 0) part[(size_t)row * 32 + u.pn * 4 + wc] = ss; }
        xcd_barrier(*bar);
#pragma unroll
        for (int ai = 0; ai < 2; ++ai)
#pragma unroll
            for (int m = 0; m < 4; ++m) { const int row = row0 + ai * HALF + m * 16; const float* pr = part + (size_t)row * 32; float tot = 0.f;
#pragma unroll
                for (int j = 0; j < 8; ++j) { const f32x4 pv = *(const f32x4*)(pr + 4 * j); tot += (pv[0] + pv[1]) + (pv[2] + pv[3]); }
                const float r = rsqrtf(tot * (1.0f / 2048.0f) + 1e-6f); const size_t ro = (size_t)row * 2048 + col0;
#pragma unroll
                for (int bj = 0; bj < 2; ++bj) { const f32x4 o0 = val[ai][bj][m][0] * r * *(const f32x4*)(g + col0 + bj * HALF), o1 = val[ai][bj][m][1] * r * *(const f32x4*)(g + col0 + bj * HALF + 4);
                    __builtin_nontemporal_store(o0, (f32x4*)(out + ro + bj * HALF)); __builtin_nontemporal_store(o1, (f32x4*)(out + ro + bj * HALF + 4)); } }
    }
};

__global__ void __launch_bounds__(NTHREADS, 2) mega_fwd(Args a) {
    extern __shared__ __attribute__((aligned(16))) unsigned char lds_raw[];
    LAS unsigned char* lds = (LAS unsigned char*)lds_raw;
    volatile LAS unsigned* bst = (volatile LAS unsigned*)(lds + LDS_BYTES - 16);
    if (threadIdx.x < 4) bst[threadIdx.x] = 0u;
    __syncthreads();
    const XcdBarrier bar = xcd_barrier_post((unsigned*)(a.ws + WS_CTL), bst);
    unsigned char* ws = a.ws; const int G = gridDim.x, bx = blockIdx.x;
    const int lo = a.ph_lo, hi = a.ph_hi;
#define IN(k) (lo <= (k) && (k) < hi)
#define STAMP(i) do { if (PROBE_TS >= 0 && bx == 0 && threadIdx.x == 0) ((volatile LAS unsigned long long*)(lds + LDS_BYTES - 256))[(i)] = __builtin_amdgcn_s_memrealtime(); } while (0)
#define SEAM(k) do { if (IN((k) + 1)) { xcd_barrier(bar); if (PROBE_DUP & 8) xcd_barrier(bar); } } while (0)
    STAMP(0);
    if (IN(0)) { phase0(a, lds); if (PROBE_DUP & 4) { __syncthreads(); phase0(a, lds); }
        if (IN(1)) { xcd_barrier_arrive(bar); wfold_prep(a); tr_run(a, lds, TR_WIN, TR_S1); xcd_barrier_wait(bar); } }
    STAMP(1);
    if (IN(1)) {
        pg8::Gemm g{(const pg8::bf16_t*)(ws + WS_XN), (const pg8::bf16_t*)(ws + WS_WINT), M, NZ, D}; pg8::StaticOrder S; S.init(M, NZ, G, bx);
        pg8::EpiZ E{(pg8::bf16_t*)(ws + WS_ZRKV), (pg8::bf16_t*)(ws + WS_GATES), (float*)(ws + WS_ZSM), (pg8::bf16_t*)(ws + WS_QLN), (float*)(ws + WS_QSS)};
        pg8::gemm_phase<pg8::EpiZ, pg8::StaticOrder, true, true>(lds, g, S, E);
        if (PROBE_DUP & 2) pg8::gemm_phase<pg8::EpiZ, pg8::StaticOrder, true, true>(lds, g, S, E);
        xcd_barrier_arrive(bar); tr_run(a, lds, TR_S1, TR_S2); xcd_barrier_wait(bar);
    }
    STAMP(2);
    STAMP(3);
    if (IN(3)) {
        pg8::Gemm g{(const pg8::bf16_t*)(ws + WS_QLN), (const pg8::bf16_t*)(ws + WS_WQIT), M, NQI, QR}; pg8::StaticOrder S; S.init(M, NQI, G, bx);
        pg8::EpiBf16Split E{(pg8::bf16_t*)a.out, 4096, 16, (pg8::bf16_t*)(ws + WS_QIDX), 1024, true};
        pg8::gemm_phase<pg8::EpiBf16Split, pg8::StaticOrder, true, true>(lds, g, S, E);
        { const int nfull = (M / 256) * (NQI / 256) % G; if (nfull == 0) phase2(a, bx, G); else if (bx >= nfull) phase2(a, bx - nfull, G - nfull); }
        __syncthreads();
    }
    STAMP(4);
    if (IN(4)) {
        for (int rep = 0; rep < ((PROBE_DUP & 1) ? 2 : 1); ++rep) rwkvA_phase(a, lds, bx & 15, bx >> 4, G >> 4);
        xcd_barrier_arrive(bar); tr_run(a, lds, TR_S2, TR_TOTAL); p_to_bf16(a); xcd_barrier_wait(bar);
    }
    STAMP(5);
    if (IN(5)) {
        if (bx < RW_WGS) { rwkvB_unit(a, lds, bx >> 4, bx & 15); if (PROBE_DUP & 32) rwkvB_unit(a, lds, bx >> 4, bx & 15); }
        STAMP(6);
        dsa_phase(a, lds, bx);
        STAMP(12);
        SEAM(5);
    }
    STAMP(7);
    if (IN(6)) { uv_phase(a, lds, bx & 15, bx >> 4, G >> 4); SEAM(6); }
    STAMP(8);
    if (IN(7)) {
        {   pg8::Gemm g{(const pg8::bf16_t*)(ws + WS_XN), (const pg8::bf16_t*)(ws + WS_WOUTT), M, D, D}; pg8::StaticOrder S; S.init(M, D, G, bx);
            pg8::EpiH E{a.in[I_X], (pg8::bf16_t*)(ws + WS_ZRKV)};
            pg8::gemm_phase<pg8::EpiH, pg8::StaticOrder, true, true>(lds, g, S, E); }
        xcd_barrier_arrive(bar);
        {   pg8::Gemm g{(const pg8::bf16_t*)(ws + WS_PBF), (const pg8::bf16_t*)(ws + WS_PLEWT), M, D, PLE}; pg8::StaticOrder S; S.init(M, D, G, bx);
            pg8::EpiBf16Split E{(pg8::bf16_t*)(ws + WS_GATES), 2048, 8, (pg8::bf16_t*)(ws + WS_GATES), 2048};
            pg8::gemm_phase<pg8::EpiBf16Split, pg8::StaticOrder, true, true>(lds, g, S, E); }
        xcd_barrier_wait(bar);
    }
    STAMP(9);
    const bool fuse_final = (G == 256) && IN(9);
    if (IN(8)) {
        pg8::Gemm g{(const pg8::bf16_t*)(ws + WS_ZRKV), (const pg8::bf16_t*)(ws + WS_WGATET), M, D, D}; pg8::StaticOrder S; S.init(M, D, G, bx);
        if (fuse_final) {
            EpiOutFused E{a.out, (const pg8::bf16_t*)(ws + WS_ZRKV), (const pg8::bf16_t*)(ws + WS_GATES), (float*)(ws + WS_PART), a.in[I_FINALG], &bar};
            pg8::gemm_phase<EpiOutFused, pg8::StaticOrder, false, true>(lds, g, S, E);
        } else {
            pg8::EpiOut E{a.out, (const pg8::bf16_t*)(ws + WS_ZRKV), (const pg8::bf16_t*)(ws + WS_GATES), (float*)(ws + WS_PART)};
            pg8::gemm_phase<pg8::EpiOut, pg8::StaticOrder, true, true>(lds, g, S, E);
            SEAM(8);
        }
    }
    STAMP(10);
    if (IN(9) && !fuse_final) phase8(a);
    STAMP(11);
    if (PROBE_TS >= 0 && bx == 0 && threadIdx.x == 0) { volatile LAS unsigned long long* ts = (volatile LAS unsigned long long*)(lds + LDS_BYTES - 256);
        const float us = (float)(ts[PROBE_TS2] - ts[PROBE_TS]) * 0.01f; __threadfence(); a.out[1] += us; }
}

#ifndef N_LAUNCHES
#define N_LAUNCHES 1
#endif
extern "C" void kernel_launch(void* const* d_in, const int* in_sizes, int n_in, void* d_out, int out_size, void* d_ws, size_t ws_size, hipStream_t stream) {
    static int grid = 0;
    if (grid == 0) {
        int dev = 0, cus = 0, per_cu = 0;
        if (n_in != 26 || out_size != M * D || ws_size < WS_END) { fprintf(stderr, "kernel_launch: unexpected shapes (n_in %d out %d ws %zu)\n", n_in, out_size, ws_size); grid = -1; return; }
        (void)hipGetDevice(&dev); (void)hipDeviceGetAttribute(&cus, hipDeviceAttributeMultiprocessorCount, dev);
        if (hipFuncSetAttribute((const void*)mega_fwd, hipFuncAttributeMaxDynamicSharedMemorySize, LDS_BYTES) != hipSuccess) { fprintf(stderr, "kernel_launch: hipFuncSetAttribute failed\n"); grid = -1; return; }
        if (hipOccupancyMaxActiveBlocksPerMultiprocessor(&per_cu, (const void*)mega_fwd, NTHREADS, LDS_BYTES) != hipSuccess || per_cu < 1) { fprintf(stderr, "kernel_launch: occupancy query says %d\n", per_cu); grid = -1; return; }
        grid = cus;
        fprintf(stderr, "kernel_launch: cus %d per_cu %d grid %d\n", cus, per_cu, grid);
    }
    if (grid < 0) return;
    Args a{};
    for (int i = 0; i < 26; ++i) a.in[i] = (const float*)d_in[i];
    a.out = (float*)d_out; a.ws = (unsigned char*)d_ws;
    const int NPH = 10;
    if (hipMemsetAsync((char*)d_ws + WS_CTL, 0, 16384, stream) != hipSuccess) { fprintf(stderr, "kernel_launch: hipMemsetAsync failed\n"); return; }
    for (int li = 0; li < N_LAUNCHES; ++li) {
        a.ph_lo = (N_LAUNCHES == 1) ? 0 : li; a.ph_hi = (N_LAUNCHES == 1) ? NPH : li + 1;
        void* args[] = {&a};
        const hipError_t e = hipLaunchCooperativeKernel((const void*)mega_fwd, dim3(grid), dim3(NTHREADS), args, LDS_BYTES, stream);
        if (e != hipSuccess) { fprintf(stderr, "kernel_launch: cooperative launch failed: %s (grid %d)\n", hipGetErrorString(e), grid); break; }
    }
}
```
